# Optimizing an MI355X kernel written in HIP

```python
import math
import jax, jax.numpy as jnp
from jax import lax
import numpy as np

D_MODEL = 1024
BATCH = 2
SEQ = 8192
DEPTH = 2

BLOCK = 128
A_WIDTH = D_MODEL // 2
A_HEAD_DIM = 64
A_HEADS = A_WIDTH // A_HEAD_DIM
A_KV_HEADS = A_HEADS // 4
WINDOW = 128
B_WIDTH = D_MODEL - A_WIDTH
SSM_GROUP = 16
SSM_GROUPS = B_WIDTH // SSM_GROUP
SSM_STATE = 64
DT_MIN = 0.001
DT_MAX = 0.1
C_WIDTH = D_MODEL
C_HEADS = A_HEADS
C_HEAD_DIM = C_WIDTH // C_HEADS
C_KV_HEADS = C_HEADS // 4
IDX_HEADS = 8
IDX_DIM = 64
TOPK_MAX = 256
NUM_BUCKETS = 32
REL_MAX_DIST = 1024
EPS = 1e-6
NEG_INF = -1e30

EVEN_SPLITS = (A_WIDTH, A_KV_HEADS * A_HEAD_DIM, A_KV_HEADS * A_HEAD_DIM, A_WIDTH, B_WIDTH, B_WIDTH)
ODD_SPLITS = (C_WIDTH, C_KV_HEADS * C_HEAD_DIM, C_KV_HEADS * C_HEAD_DIM, C_WIDTH,
              IDX_HEADS * IDX_DIM, IDX_DIM, IDX_HEADS)
N_EVEN = (DEPTH + 1) // 2
N_ODD = DEPTH // 2

kernel_name = 'hybrid_swa_s5_dsa_block'


def rms_norm(x, g):
    xf = x.astype(jnp.float32)
    y = xf * lax.rsqrt(jnp.mean(xf * xf, axis=-1, keepdims=True) + EPS)
    return (y * g.astype(jnp.float32)).astype(x.dtype)


def split_cols(z, sizes):
    idx = np.cumsum(sizes)[:-1].tolist()
    return jnp.split(z, idx, axis=-1)


def t5_bucket(dist):
    n = jnp.maximum(dist, 0)
    max_exact = NUM_BUCKETS // 2
    nf = jnp.maximum(n, 1).astype(jnp.float32)
    large = max_exact + (jnp.log(nf / max_exact) / math.log(REL_MAX_DIST / max_exact)
                         * (NUM_BUCKETS - max_exact)).astype(jnp.int32)
    large = jnp.minimum(large, NUM_BUCKETS - 1)
    return jnp.where(n < max_exact, n, large)


def swa_sink_attention(q, k, v, sinks, rel_bias):
    bsz, L, H, Dh = q.shape
    hkv = k.shape[2]
    G = H // hkv
    nb = L // BLOCK
    qb = q.reshape(bsz, nb, BLOCK, hkv, G, Dh)
    kb = k.reshape(bsz, nb, BLOCK, hkv, Dh)
    vb = v.reshape(bsz, nb, BLOCK, hkv, Dh)
    k_band = jnp.concatenate([jnp.concatenate([jnp.zeros_like(kb[:, :1]), kb[:, :-1]], axis=1), kb], axis=2)
    v_band = jnp.concatenate([jnp.concatenate([jnp.zeros_like(vb[:, :1]), vb[:, :-1]], axis=1), vb], axis=2)
    logits = jnp.einsum('bnqhgd,bnkhd->bnhgqk', qb, k_band).astype(jnp.float32) * (Dh ** -0.5)
    i = jnp.arange(BLOCK, dtype=jnp.int32)[:, None]
    j = jnp.arange(2 * BLOCK, dtype=jnp.int32)[None, :]
    d = i + BLOCK - j
    in_window = (d >= 0) & (d < WINDOW)
    first = (jnp.arange(nb) == 0)[:, None, None] & (j < BLOCK)[None]
    mask = in_window[None] & ~first
    bias = rel_bias[t5_bucket(d)].astype(jnp.float32)
    bias = bias.transpose(2, 0, 1).reshape(hkv, G, BLOCK, 2 * BLOCK)
    logits = jnp.where(mask[None, :, None, None], logits + bias, NEG_INF)
    sink = jnp.broadcast_to(sinks.astype(jnp.float32).reshape(1, 1, hkv, G, 1, 1), logits.shape[:-1] + (1,))
    p = jax.nn.softmax(jnp.concatenate([logits, sink], axis=-1), axis=-1)[..., :-1]
    out = jnp.einsum('bnhgqk,bnkhd->bnqhgd', p.astype(v.dtype), v_band)
    return out.reshape(bsz, L, H * Dh)


def ssm_combine(e1, e2):
    a1r, a1i, b1r, b1i = e1
    a2r, a2i, b2r, b2i = e2
    ar = a1r * a2r - a1i * a2i
    ai = a1r * a2i + a1i * a2r
    br = a2r * b1r - a2i * b1i + b2r
    bi = a2r * b1i + a2i * b1r + b2i
    return (ar, ai, br, bi)


def s5_mixer(u, log_dt, a_re, a_im, b_re, b_im, c_re, c_im, d_skip, glu_w, glu_b):
    bsz, L, W = u.shape
    G, P = a_re.shape
    ug = u.reshape(bsz, L, G, W // G)
    dt = jnp.exp(log_dt)[:, None]
    mag = jnp.exp(a_re * dt)
    ang = a_im * dt
    ab_re = mag * jnp.cos(ang)
    ab_im = mag * jnp.sin(ang)
    den = a_re * a_re + a_im * a_im
    n_re = ab_re - 1.0
    n_im = ab_im
    f_re = (n_re * a_re + n_im * a_im) / den
    f_im = (n_im * a_re - n_re * a_im) / den
    bb_re = f_re[..., None] * b_re - f_im[..., None] * b_im
    bb_im = f_re[..., None] * b_im + f_im[..., None] * b_re
    bu_re = jnp.einsum('blgh,gph->blgp', ug, bb_re)
    bu_im = jnp.einsum('blgh,gph->blgp', ug, bb_im)
    at_re = jnp.broadcast_to(ab_re[None, None], (1, L, G, P))
    at_im = jnp.broadcast_to(ab_im[None, None], (1, L, G, P))
    _, _, x_re, x_im = lax.associative_scan(ssm_combine, (at_re, at_im, bu_re, bu_im), axis=1)
    y = (jnp.einsum('blgp,ghp->blgh', x_re, c_re) - jnp.einsum('blgp,ghp->blgh', x_im, c_im)
         + d_skip * ug)
    y = jax.nn.gelu(y.reshape(bsz, L, W))
    h = y @ glu_w + glu_b
    return h[..., :W] * jax.nn.sigmoid(h[..., W:])


def dsa_attention(q, k, v, qi, ki, wi, rel_bias):
    bsz, L, H, Dh = q.shape
    hkv = k.shape[2]
    G = H // hkv
    nb = L // BLOCK
    topk = min(TOPK_MAX, L // 4)
    qb = q.reshape(bsz, nb, BLOCK, hkv, G, Dh).transpose(1, 0, 2, 3, 4, 5)
    qib = qi.reshape(bsz, nb, BLOCK, IDX_HEADS, IDX_DIM).transpose(1, 0, 2, 3, 4)
    wib = wi.reshape(bsz, nb, BLOCK, IDX_HEADS).transpose(1, 0, 2, 3)
    starts = jnp.arange(nb, dtype=jnp.int32) * BLOCK
    key_pos = jnp.arange(L, dtype=jnp.int32)

    def one_block(args):
        q_blk, qi_blk, w_blk, start = args
        t = start + jnp.arange(BLOCK, dtype=jnp.int32)
        rel = jax.nn.relu(jnp.einsum('bqhd,bsd->bqhs', qi_blk, ki).astype(jnp.float32) * (IDX_DIM ** -0.5))
        score = jnp.einsum('bqhs,bqh->bqs', rel, w_blk.astype(jnp.float32))
        score = jnp.where(key_pos[None, None, :] <= t[None, :, None], score, NEG_INF)
        _, idx = lax.top_k(score, topk)
        valid = idx <= t[None, :, None]
        k_sel = jax.vmap(lambda kk, ii: kk[ii])(k, idx)
        v_sel = jax.vmap(lambda vv, ii: vv[ii])(v, idx)
        logits = jnp.einsum('bqhgd,bqkhd->bqhgk', q_blk, k_sel).astype(jnp.float32) * (Dh ** -0.5)
        bias = rel_bias[t5_bucket(t[None, :, None] - idx)].astype(jnp.float32)
        bias = bias.reshape(bsz, BLOCK, topk, hkv, G).transpose(0, 1, 3, 4, 2)
        logits = jnp.where(valid[:, :, None, None, :], logits + bias, NEG_INF)
        p = jax.nn.softmax(logits, axis=-1).astype(v.dtype)
        return jnp.einsum('bqhgk,bqkhd->bqhgd', p, v_sel)

    out = lax.map(one_block, (qb, qib, wib, starts))
    return out.transpose(1, 0, 2, 3, 4, 5).reshape(bsz, L, H * Dh)


def even_layer(hn, rel_bias, w_in, w_out, q_g, k_g, sinks, log_dt, a_re, a_im, b_re, b_im,
               c_re, c_im, d_skip, glu_w, glu_b):
    bsz, L, _ = hn.shape
    q, k, v, gate_a, u, gate_b = split_cols(hn @ w_in, EVEN_SPLITS)
    q = rms_norm(q.reshape(bsz, L, A_HEADS, A_HEAD_DIM), q_g)
    k = rms_norm(k.reshape(bsz, L, A_KV_HEADS, A_HEAD_DIM), k_g)
    v = v.reshape(bsz, L, A_KV_HEADS, A_HEAD_DIM)
    att = swa_sink_attention(q, k, v, sinks, rel_bias) * jax.nn.silu(gate_a)
    ssm = s5_mixer(u, log_dt, a_re, a_im, b_re, b_im, c_re, c_im, d_skip, glu_w, glu_b) * jax.nn.silu(gate_b)
    return jnp.concatenate([att, ssm], axis=-1) @ w_out


def odd_layer(hn, rel_bias, w_in, w_out, q_g, k_g):
    bsz, L, _ = hn.shape
    q, k, v, gate, qi, ki, wi = split_cols(hn @ w_in, ODD_SPLITS)
    q = rms_norm(q.reshape(bsz, L, C_HEADS, C_HEAD_DIM), q_g)
    k = rms_norm(k.reshape(bsz, L, C_KV_HEADS, C_HEAD_DIM), k_g)
    v = v.reshape(bsz, L, C_KV_HEADS, C_HEAD_DIM)
    qi = qi.reshape(bsz, L, IDX_HEADS, IDX_DIM)
    wi = wi * (IDX_HEADS ** -0.5)
    att = dsa_attention(q, k, v, qi, ki, wi, rel_bias)
    return (att * jax.nn.silu(gate)) @ w_out


def setup_inputs(seed: int = 0) -> dict:
    key = jax.random.key(seed)
    ks = jax.random.split(key, 24)
    f32 = jnp.float32

    def nrm(k, shape, s):
        return jax.random.normal(k, shape, f32) * s

    ev_in = sum(EVEN_SPLITS)
    od_in = sum(ODD_SPLITS)
    ssm_n = jnp.arange(SSM_STATE, dtype=f32)
    return {
        'x': nrm(ks[0], (BATCH, SEQ, D_MODEL), 1.0),
        'rel_bias': nrm(ks[1], (NUM_BUCKETS, A_HEADS), 0.5),
        'norm_g': 1.0 + nrm(ks[2], (DEPTH, D_MODEL), 0.02),
        'ev_w_in': nrm(ks[3], (N_EVEN, D_MODEL, ev_in), D_MODEL ** -0.5),
        'ev_w_out': nrm(ks[4], (N_EVEN, A_WIDTH + B_WIDTH, D_MODEL), (A_WIDTH + B_WIDTH) ** -0.5),
        'ev_q_norm_g': 1.0 + nrm(ks[5], (N_EVEN, A_HEAD_DIM), 0.02),
        'ev_k_norm_g': 1.0 + nrm(ks[6], (N_EVEN, A_HEAD_DIM), 0.02),
        'ev_sinks': nrm(ks[7], (N_EVEN, A_HEADS), 1.0),
        'ev_ssm_log_dt': jax.random.uniform(ks[8], (N_EVEN, SSM_GROUPS), f32, math.log(DT_MIN), math.log(DT_MAX)),
        'ev_ssm_a_re': -0.5 + nrm(ks[9], (N_EVEN, SSM_GROUPS, SSM_STATE), 0.01),
        'ev_ssm_a_im': jnp.pi * ssm_n + nrm(ks[10], (N_EVEN, SSM_GROUPS, SSM_STATE), 0.01),
        'ev_ssm_b_re': nrm(ks[11], (N_EVEN, SSM_GROUPS, SSM_STATE, SSM_GROUP), (2 * SSM_GROUP) ** -0.5),
        'ev_ssm_b_im': nrm(ks[12], (N_EVEN, SSM_GROUPS, SSM_STATE, SSM_GROUP), (2 * SSM_GROUP) ** -0.5),
        'ev_ssm_c_re': nrm(ks[13], (N_EVEN, SSM_GROUPS, SSM_GROUP, SSM_STATE), (2 * SSM_STATE) ** -0.5),
        'ev_ssm_c_im': nrm(ks[14], (N_EVEN, SSM_GROUPS, SSM_GROUP, SSM_STATE), (2 * SSM_STATE) ** -0.5),
        'ev_ssm_d': nrm(ks[15], (N_EVEN, SSM_GROUPS, SSM_GROUP), 1.0),
        'ev_glu_w': nrm(ks[16], (N_EVEN, B_WIDTH, 2 * B_WIDTH), B_WIDTH ** -0.5),
        'ev_glu_b': nrm(ks[17], (N_EVEN, 2 * B_WIDTH), 0.01),
        'od_w_in': nrm(ks[18], (N_ODD, D_MODEL, od_in), D_MODEL ** -0.5),
        'od_w_out': nrm(ks[19], (N_ODD, C_WIDTH, D_MODEL), C_WIDTH ** -0.5),
        'od_q_norm_g': 1.0 + nrm(ks[20], (N_ODD, C_HEAD_DIM), 0.02),
        'od_k_norm_g': 1.0 + nrm(ks[21], (N_ODD, C_HEAD_DIM), 0.02),
    }


def reference(x, rel_bias, norm_g, ev_w_in, ev_w_out, ev_q_norm_g, ev_k_norm_g, ev_sinks,
              ev_ssm_log_dt, ev_ssm_a_re, ev_ssm_a_im, ev_ssm_b_re, ev_ssm_b_im, ev_ssm_c_re,
              ev_ssm_c_im, ev_ssm_d, ev_glu_w, ev_glu_b, od_w_in, od_w_out, od_q_norm_g, od_k_norm_g):
    h = x
    for layer in range(DEPTH):
        hn = rms_norm(h, norm_g[layer])
        j = layer // 2
        if layer % 2 == 0:
            out = even_layer(hn, rel_bias, ev_w_in[j], ev_w_out[j], ev_q_norm_g[j], ev_k_norm_g[j],
                             ev_sinks[j], ev_ssm_log_dt[j], ev_ssm_a_re[j], ev_ssm_a_im[j],
                             ev_ssm_b_re[j], ev_ssm_b_im[j], ev_ssm_c_re[j], ev_ssm_c_im[j],
                             ev_ssm_d[j], ev_glu_w[j], ev_glu_b[j])
        else:
            out = odd_layer(hn, rel_bias, od_w_in[j], od_w_out[j], od_q_norm_g[j], od_k_norm_g[j])
        h = h + out
    return h
```

```cpp
#include <hip/hip_runtime.h>
#include <stdint.h>
#include <stdio.h>

#ifndef ONE_LAUNCH
#define ONE_LAUNCH 0
#endif

typedef _Float16 hf;
typedef _Float16 h8 __attribute__((ext_vector_type(8)));
typedef _Float16 h4 __attribute__((ext_vector_type(4)));
typedef float f4 __attribute__((ext_vector_type(4)));
typedef unsigned u32;
typedef unsigned short u16;
typedef __fp16 fp16x4_t __attribute__((__vector_size__(4 * sizeof(__fp16))));
#define LAS __attribute__((address_space(3)))

constexpr int NTHR = 512;
constexpr int SEQ = 8192, DM = 1024, MTOK = 2 * SEQ;
constexpr int N0 = 2304, N1 = 3144, N1P = 3328;
constexpr int NPHASE = 10;
constexpr int LDS_BYTES = 104 * 1024;

constexpr size_t MiB = 1024 * 1024;
constexpr size_t WS_BAR    = 0;
constexpr size_t WS_WT_IN0 = 64 * 1024;
constexpr size_t WS_WT_OUT0 = WS_WT_IN0 + (size_t)N0 * 1024 * 2;
constexpr size_t WS_WT_GLU = WS_WT_OUT0 + (size_t)1024 * 1024 * 2;
constexpr size_t WS_WT_IN1 = WS_WT_GLU + (size_t)1024 * 512 * 2;
constexpr size_t WS_WT_OUT1 = WS_WT_IN1 + (size_t)N1P * 1024 * 2;
constexpr size_t WS_TAB    = WS_WT_OUT1 + (size_t)1024 * 1024 * 2;
constexpr size_t TAB_AB   = 0;
constexpr size_t TAB_AT   = 16384;
constexpr size_t TAB_DT   = 32768;
constexpr size_t TAB_BBS  = 33792;
constexpr size_t TAB_CRI  = TAB_BBS + 131072;
constexpr size_t TAB_BIAS0 = TAB_CRI + 131072;
constexpr size_t TAB_BKT  = TAB_BIAS0 + 4096;
constexpr size_t TAB_SIZE = 512 * 1024;
constexpr size_t WS_RA = 18 * MiB;
constexpr size_t WS_RB = WS_RA + 32 * MiB;
constexpr size_t WS_RC = WS_RB + 72 * MiB;
constexpr size_t WS_V1 = WS_RC + 16 * MiB;
constexpr size_t WS_KI = WS_V1 + 8 * MiB;
constexpr size_t WS_WI = WS_KI + 2 * MiB;
constexpr size_t WS_LIST = WS_WI + MiB;
constexpr size_t WS_CNT = WS_LIST + 8 * MiB;
constexpr size_t WS_SC = WS_CNT + MiB;
constexpr size_t WS_V0T = WS_SC + 4 * MiB;
constexpr size_t WS_ROWSS = WS_V0T + 4 * MiB;
constexpr size_t WS_END = WS_ROWSS + MiB;

struct Params {
    const float* in[22];
    float* out;
    unsigned char* ws;
    int ph_lo, ph_hi;
};

__device__ __forceinline__ float silu_f(float x) { return x / (1.0f + __expf(-x)); }
__device__ __forceinline__ float sigmoid_f(float x) { return 1.0f / (1.0f + __expf(-x)); }
__device__ __forceinline__ float gelu_tanh_f(float x) {
    const float z = 0.7978845608028654f * (x + 0.044715f * x * x * x);
    const float e = __expf(2.0f * z);
    const float th = 1.0f - 2.0f / (e + 1.0f);
    return 0.5f * x * (1.0f + th);
}
__device__ __forceinline__ float red16(float v) {
    v += __shfl_xor(v, 1); v += __shfl_xor(v, 2); v += __shfl_xor(v, 4); v += __shfl_xor(v, 8); return v;
}
__device__ __forceinline__ int fsw(int row) { return (0x78 >> (((row >> 2) & 3) * 2)) & 3; }
#define LDS_FENCE() asm volatile("s_waitcnt lgkmcnt(0)" ::: "memory")

#define XB_TMO      128
#define XB_XCNT(j)  (256  + 64 * (j))
#define XB_XSUB(j)  (1280 + 64 * (j))
#define XB_XGEN(j)  (2304 + 64 * (j))
#define XB_TOP      3328
#define XB_TOPGEN   3392
#define XCD_BAR_WORDS 3456
#define XB_SPIN_CAP (1u << 22)
__device__ __forceinline__ unsigned xb_ld(unsigned* p)              { return __hip_atomic_load(p, __ATOMIC_RELAXED, __HIP_MEMORY_SCOPE_AGENT); }
__device__ __forceinline__ unsigned xb_add(unsigned* p, unsigned v) { return __hip_atomic_fetch_add(p, v, __ATOMIC_RELAXED, __HIP_MEMORY_SCOPE_AGENT); }
__device__ __forceinline__ unsigned xb_xcc_id() { return (unsigned)__builtin_amdgcn_s_getreg((3 << 11) | 20) & 0xFu; }
#define XB_SPIN(cond, bar) do { unsigned _sp = 0; while (cond) { __builtin_amdgcn_s_sleep(1); \
    if ((++_sp & 255u) == 0u) { if (xb_ld(&(bar)[XB_TMO])) break; if (_sp > XB_SPIN_CAP) { atomicAdd(&(bar)[XB_TMO], 1u); break; } } } } while (0)
struct XcdBarrier { unsigned* bar; unsigned x; volatile LAS unsigned* st; };
__device__ __forceinline__ XcdBarrier xcd_barrier_post(unsigned* bar, volatile LAS unsigned* st) {
    XcdBarrier b; b.bar = bar; b.x = xb_xcc_id(); b.st = st;
    if (threadIdx.x == 0) (void)xb_add(&bar[XB_XCNT(b.x)], 1u);
    return b;
}
__device__ __forceinline__ void xcd_barrier_complete(unsigned* bar, unsigned x, unsigned& nloc, unsigned& nx) {
    const unsigned G = gridDim.x;
    unsigned sum, cnt, mine, sp = 0u;
    for (;;) {
        sum = 0u; cnt = 0u; mine = 0u;
#pragma unroll
        for (unsigned j = 0; j < 16; ++j) { const unsigned c = xb_ld(&bar[XB_XCNT(j)]); sum += c; cnt += (c > 0u) ? 1u : 0u; mine = (j == x) ? c : mine; }
        if (sum == G) break;
        __builtin_amdgcn_s_sleep(1);
        if ((++sp & 255u) == 0u) { if (xb_ld(&bar[XB_TMO])) break; if (sp > XB_SPIN_CAP) { atomicAdd(&bar[XB_TMO], 1u); break; } }
    }
    nloc = mine > 0u ? mine : 1u; nx = cnt > 0u ? cnt : 1u;
}
__device__ __forceinline__ void xcd_barrier(const XcdBarrier& b) {
    asm volatile("s_waitcnt vmcnt(0)" ::: "memory");
    __syncthreads();
    if (threadIdx.x == 0) {
        unsigned* bar = b.bar;
        __builtin_amdgcn_s_waitcnt(0);
        unsigned nloc = b.st[0], nx = b.st[1];
        if (nloc == 0u) { xcd_barrier_complete(bar, b.x, nloc, nx); b.st[0] = nloc; b.st[1] = nx; }
        const unsigned old = xb_add(&bar[XB_XSUB(b.x)], 1u);
        const unsigned gen = old / nloc;
        if (old + 1u == (gen + 1u) * nloc) {
            __builtin_amdgcn_fence(__ATOMIC_RELEASE, "agent");
            asm volatile("s_waitcnt vmcnt(0)" ::: "memory");
            const unsigned og = xb_add(&bar[XB_TOP], 1u);
            const unsigned tg = og / nx;
            if (og + 1u == (tg + 1u) * nx) xb_add(&bar[XB_TOPGEN], 1u);
            else XB_SPIN(xb_ld(&bar[XB_TOPGEN]) == tg, bar);
            __builtin_amdgcn_fence(__ATOMIC_ACQUIRE, "agent");
            xb_add(&bar[XB_XGEN(b.x)], 1u);
            asm volatile("s_waitcnt vmcnt(0)" ::: "memory");
        } else {
            XB_SPIN(xb_ld(&bar[XB_XGEN(b.x)]) == gen, bar);
            __builtin_amdgcn_fence(__ATOMIC_ACQUIRE, "agent");
            asm volatile("s_waitcnt vmcnt(0)" ::: "memory");
        }
    }
    __syncthreads();
}

__device__ __forceinline__ void transpose_tile(const float* __restrict__ src, int K, int N, hf* dst, int k0, int n0, int mode, float* tile) {
    const int tid = threadIdx.x;
#pragma unroll
    for (int i = 0; i < 8; ++i) {
        const int kk = (tid >> 6) + 8 * i, nn = tid & 63, n = n0 + nn;
        tile[kk * 65 + nn] = (n < N) ? src[(size_t)(k0 + kk) * N + n] : 0.0f;
    }
    __syncthreads();
    {
        const int nn = tid >> 3, kc = tid & 7, n = n0 + nn;
        int drow = n;
        if (mode == 1) { const int j = n & 511, half = n >> 9; drow = (j >> 4) * 32 + half * 16 + (j & 15); }
        h8 v;
#pragma unroll
        for (int j = 0; j < 8; ++j) v[j] = (hf)tile[(kc * 8 + j) * 65 + nn];
        *(h8*)(dst + (size_t)drow * K + k0 + kc * 8) = v;
    }
    __syncthreads();
}

__device__ __forceinline__ void p0_prep(const Params& P, char* smem) {
    const int tid = threadIdx.x, lane = tid & 63, w = tid >> 6;
    unsigned char* ws = P.ws;
    for (int it = blockIdx.x; it < 2048; it += gridDim.x) {
        const float* src; hf* dst; int K, N, ntl, mode = 0, loc;
        if (it < 576)       { loc = it;        src = P.in[3];  dst = (hf*)(ws + WS_WT_IN0);  K = 1024; N = N0;   ntl = 36; }
        else if (it < 832)  { loc = it - 576;  src = P.in[4];  dst = (hf*)(ws + WS_WT_OUT0); K = 1024; N = 1024; ntl = 16; }
        else if (it < 960)  { loc = it - 832;  src = P.in[16]; dst = (hf*)(ws + WS_WT_GLU);  K = 512;  N = 1024; ntl = 16; mode = 1; }
        else if (it < 1792) { loc = it - 960;  src = P.in[18]; dst = (hf*)(ws + WS_WT_IN1);  K = 1024; N = N1;   ntl = 52; }
        else                { loc = it - 1792; src = P.in[19]; dst = (hf*)(ws + WS_WT_OUT1); K = 1024; N = 1024; ntl = 16; }
        const int kt = loc / ntl, nt = loc % ntl;
        transpose_tile(src, K, N, dst, kt * 64, nt * 64, mode, (float*)smem);
    }
    {
        const float* x = P.in[0]; const float* g = P.in[2];
        hf* hn0 = (hf*)(ws + WS_RA);
        f4 gv[4];
#pragma unroll
        for (int i = 0; i < 4; ++i) gv[i] = *(const f4*)(g + i * 256 + lane * 4);
        for (int row = blockIdx.x * 8 + w; row < MTOK; row += gridDim.x * 8) {
            f4 v[4]; float ss = 0.f;
#pragma unroll
            for (int i = 0; i < 4; ++i) { v[i] = *(const f4*)(x + (size_t)row * DM + i * 256 + lane * 4); ss += v[i][0] * v[i][0] + v[i][1] * v[i][1] + v[i][2] * v[i][2] + v[i][3] * v[i][3]; }
#pragma unroll
            for (int o = 1; o < 64; o <<= 1) ss += __shfl_xor(ss, o);
            const float rs = rsqrtf(ss * (1.0f / 1024.0f) + 1e-6f);
#pragma unroll
            for (int i = 0; i < 4; ++i) {
                h4 o; o[0] = (hf)(v[i][0] * rs * gv[i][0]); o[1] = (hf)(v[i][1] * rs * gv[i][1]); o[2] = (hf)(v[i][2] * rs * gv[i][2]); o[3] = (hf)(v[i][3] * rs * gv[i][3]);
                *(h4*)(hn0 + (size_t)row * DM + i * 256 + lane * 4) = o;
            }
        }
    }
    {
        const int gt = blockIdx.x * NTHR + tid;
        if (gt < 2048) {
            const int g = gt >> 6, p = gt & 63;
            const double dt = exp((double)P.in[8][g]);
            const double ar = (double)P.in[9][gt], ai = (double)P.in[10][gt];
            const double mag = exp(ar * dt), ang = ai * dt;
            const double abr = mag * cos(ang), abi = mag * sin(ang);
            const double den = ar * ar + ai * ai;
            const double em1 = expm1(ar * dt);
            const double s2 = sin(0.5 * ang);
            const double nr = em1 * cos(ang) - 2.0 * s2 * s2, ni = abi;
            const double fr = (nr * ar + ni * ai) / den, fi = (ni * ar - nr * ai) / den;
            float* tab_ab = (float*)(ws + WS_TAB + TAB_AB); float* tab_at = (float*)(ws + WS_TAB + TAB_AT);
            tab_ab[gt * 2] = (float)abr; tab_ab[gt * 2 + 1] = (float)abi;
            double pr = abr, pi = abi;
#pragma unroll
            for (int i = 0; i < 6; ++i) { const double nr2 = pr * pr - pi * pi, ni2 = 2.0 * pr * pi; pr = nr2; pi = ni2; }
            tab_at[gt * 2] = (float)pr; tab_at[gt * 2 + 1] = (float)pi;
            if (p == 0) ((float*)(ws + WS_TAB + TAB_DT))[g] = (float)dt;
            hf* bbs = (hf*)(ws + WS_TAB + TAB_BBS); hf* cri = (hf*)(ws + WS_TAB + TAB_CRI);
            const double inv_dt = 1.0 / dt;
            for (int h = 0; h < 16; ++h) {
                const double br = (double)P.in[11][(size_t)gt * 16 + h], bi = (double)P.in[12][(size_t)gt * 16 + h];
                bbs[((size_t)g * 128 + p) * 16 + h]      = (hf)(float)((fr * br - fi * bi) * inv_dt);
                bbs[((size_t)g * 128 + 64 + p) * 16 + h] = (hf)(float)((fr * bi + fi * br) * inv_dt);
                cri[((size_t)g * 16 + h) * 128 + p]      = (hf)P.in[13][((size_t)g * 16 + h) * 64 + p];
                cri[((size_t)g * 16 + h) * 128 + 64 + p] = (hf)(-P.in[14][((size_t)g * 16 + h) * 64 + p]);
            }
        }
    }
    {
        const int gt = blockIdx.x * NTHR + tid;
        if (gt < 8192) {
            const int d = gt;
            int bk;
            if (d < 16) bk = d;
            else {
                const int thr[15] = {21, 27, 35, 46, 59, 77, 99, 128, 166, 216, 280, 363, 470, 609, 790};
                bk = 16;
#pragma unroll
                for (int i = 0; i < 15; ++i) bk += (d >= thr[i]) ? 1 : 0;
            }
            ((unsigned char*)(ws + WS_TAB + TAB_BKT))[d] = (unsigned char)bk;
            if (d < 128) {
                float* b0 = (float*)(ws + WS_TAB + TAB_BIAS0);
#pragma unroll
                for (int h = 0; h < 8; ++h) b0[h * 128 + d] = P.in[1][bk * 8 + h];
            }
        }
    }
}

enum { EPI_IN0 = 0, EPI_GLU = 1, EPI_OUT0 = 2, EPI_IN1 = 3, EPI_OUT1 = 4 };

template <int EPI>
__device__ __forceinline__ void gemm_epilogue(const Params& P, f4 (&acc)[4][4], int pm, int pn, int wm, int wn, int lane, char* smem) {
    unsigned char* ws = P.ws;
    const int l15 = lane & 15, g4 = lane >> 4;
    const int c0 = pn * 256 + wn * 64;
    const int rbase = pm * 128 + wm * 64 + 4 * g4;
    if (EPI == EPI_IN0) {
        hf* z0 = (hf*)(ws + WS_RB);
        if (c0 < 640) {
            const float* gw = (c0 < 512) ? P.in[5] : P.in[6];
            float gv[4];
#pragma unroll
            for (int nt = 0; nt < 4; ++nt) gv[nt] = gw[nt * 16 + l15];
#pragma unroll
            for (int mt = 0; mt < 4; ++mt)
#pragma unroll
                for (int r = 0; r < 4; ++r) {
                    float ss = 0.f;
#pragma unroll
                    for (int nt = 0; nt < 4; ++nt) ss += acc[mt][nt][r] * acc[mt][nt][r];
                    ss = red16(ss);
                    const float sc = rsqrtf(ss * (1.0f / 64.0f) + 1e-6f);
                    const size_t row = rbase + mt * 16 + r;
#pragma unroll
                    for (int nt = 0; nt < 4; ++nt) z0[row * N0 + c0 + nt * 16 + l15] = (hf)(acc[mt][nt][r] * sc * gv[nt]);
                }
        } else if (c0 < 768) {
            hf* v0t = (hf*)(ws + WS_V0T);
#pragma unroll
            for (int mt = 0; mt < 4; ++mt) {
                const int row = rbase + mt * 16;
                const int b = row >> 13, tok = row & 8191;
#pragma unroll
                for (int nt = 0; nt < 4; ++nt) {
                    h4 o; o[0] = (hf)acc[mt][nt][0]; o[1] = (hf)acc[mt][nt][1]; o[2] = (hf)acc[mt][nt][2]; o[3] = (hf)acc[mt][nt][3];
                    *(h4*)(v0t + ((size_t)(b * 128 + (c0 - 640) + nt * 16 + l15)) * SEQ + tok) = o;
                }
            }
        } else {
            const bool is_u = (c0 >= 1280 && c0 < 1792);
#pragma unroll
            for (int mt = 0; mt < 4; ++mt)
#pragma unroll
                for (int r = 0; r < 4; ++r) {
                    const size_t row = rbase + mt * 16 + r;
#pragma unroll
                    for (int nt = 0; nt < 4; ++nt) { const float v = acc[mt][nt][r]; z0[row * N0 + c0 + nt * 16 + l15] = (hf)(is_u ? v : silu_f(v)); }
                }
        }
    } else if (EPI == EPI_GLU) {
        const hf* z0 = (const hf*)(ws + WS_RB); hf* cat = (hf*)(ws + WS_RA);
        const float* gb = P.in[17];
#pragma unroll
        for (int i = 0; i < 2; ++i) {
            const int j = ((c0 >> 4) + 2 * i) / 2 * 16 + l15;
            const float ba = gb[j], bb = gb[512 + j];
#pragma unroll
            for (int mt = 0; mt < 4; ++mt)
#pragma unroll
                for (int r = 0; r < 4; ++r) {
                    const size_t row = rbase + mt * 16 + r;
                    const float a = acc[mt][2 * i][r] + ba, b = acc[mt][2 * i + 1][r] + bb;
                    const float sg = (float)z0[row * N0 + 1792 + j];
                    cat[row * DM + 512 + j] = (hf)(a * sigmoid_f(b) * sg);
                }
        }
    } else if (EPI == EPI_OUT0) {
        const float* x = P.in[0]; const float* g1 = P.in[2] + DM;
        hf* h1g = (hf*)(ws + WS_RB); float* rowss = (float*)(ws + WS_ROWSS);
        float gv[4];
#pragma unroll
        for (int nt = 0; nt < 4; ++nt) gv[nt] = g1[c0 + nt * 16 + l15];
#pragma unroll
        for (int mt = 0; mt < 4; ++mt)
#pragma unroll
            for (int r = 0; r < 4; ++r) {
                const size_t row = rbase + mt * 16 + r;
                float ss = 0.f;
#pragma unroll
                for (int nt = 0; nt < 4; ++nt) {
                    const size_t idx = row * DM + c0 + nt * 16 + l15;
                    const float h = x[idx] + acc[mt][nt][r];
                    P.out[idx] = h; h1g[idx] = (hf)(h * gv[nt]); ss += h * h;
                }
                ss = red16(ss);
                if (l15 == 0) rowss[row * 16 + (c0 >> 6)] = ss;
            }
    } else if (EPI == EPI_IN1) {
        const float* rsrow = (const float*)(smem + 49152);
        float* xch = (float*)(smem + 49152 + 512);
        const int w = wm * 4 + wn;
#pragma unroll
        for (int mt = 0; mt < 4; ++mt)
#pragma unroll
            for (int r = 0; r < 4; ++r) {
                const float rs = rsrow[wm * 64 + mt * 16 + 4 * g4 + r];
#pragma unroll
                for (int nt = 0; nt < 4; ++nt) acc[mt][nt][r] *= rs;
            }
        if (pn < 5) {
            float ssl[4][4];
#pragma unroll
            for (int mt = 0; mt < 4; ++mt)
#pragma unroll
                for (int r = 0; r < 4; ++r) {
                    float ss = 0.f;
#pragma unroll
                    for (int nt = 0; nt < 4; ++nt) ss += acc[mt][nt][r] * acc[mt][nt][r];
                    ss = red16(ss); ssl[mt][r] = ss;
                    if (l15 == 0) xch[w * 64 + mt * 16 + 4 * g4 + r] = ss;
                }
            __syncthreads();
            const float* gw = (pn < 4) ? P.in[20] : P.in[21];
            float gv[4];
#pragma unroll
            for (int nt = 0; nt < 4; ++nt) gv[nt] = gw[(c0 & 64) + nt * 16 + l15];
            hf* dst = (pn < 4) ? (hf*)(ws + WS_RA) : (hf*)(ws + WS_RB + 64 * MiB);
            const int ld = (pn < 4) ? 1024 : 256, cc = (pn < 4) ? c0 : (c0 - 1024);
#pragma unroll
            for (int mt = 0; mt < 4; ++mt)
#pragma unroll
                for (int r = 0; r < 4; ++r) {
                    const float tot = ssl[mt][r] + xch[(w ^ 1) * 64 + mt * 16 + 4 * g4 + r];
                    const float sc = rsqrtf(tot * (1.0f / 128.0f) + 1e-6f);
                    const size_t row = rbase + mt * 16 + r;
#pragma unroll
                    for (int nt = 0; nt < 4; ++nt) dst[row * ld + cc + nt * 16 + l15] = (hf)(acc[mt][nt][r] * sc * gv[nt]);
                }
        } else {
            hf* dst; int ld, cc; bool act = false;
            if (c0 < 1536)      { dst = (hf*)(ws + WS_V1); ld = 256; cc = c0 - 1280; }
            else if (c0 < 2560) { dst = (hf*)(ws + WS_RB + 32 * MiB); ld = 1024; cc = c0 - 1536; act = true; }
            else if (c0 < 3072) { dst = (hf*)(ws + WS_RC); ld = 512; cc = c0 - 2560; }
            else                { dst = (hf*)(ws + WS_KI); ld = 64; cc = 0; }
            if (c0 <= 3072) {
#pragma unroll
                for (int mt = 0; mt < 4; ++mt)
#pragma unroll
                    for (int r = 0; r < 4; ++r) {
                        const size_t row = rbase + mt * 16 + r;
#pragma unroll
                        for (int nt = 0; nt < 4; ++nt) { const float v = acc[mt][nt][r]; dst[row * ld + cc + nt * 16 + l15] = (hf)(act ? silu_f(v) : v); }
                    }
            } else if (c0 == 3136) {
                float* wi = (float*)(ws + WS_WI);
                if (l15 < 8) {
#pragma unroll
                    for (int mt = 0; mt < 4; ++mt)
#pragma unroll
                        for (int r = 0; r < 4; ++r) { const size_t row = rbase + mt * 16 + r; wi[row * 8 + l15] = acc[mt][0][r] * 0.04419417382415922f; }
                }
            }
        }
    } else {
#pragma unroll
        for (int mt = 0; mt < 4; ++mt)
#pragma unroll
            for (int r = 0; r < 4; ++r) {
                const size_t row = rbase + mt * 16 + r;
#pragma unroll
                for (int nt = 0; nt < 4; ++nt) { const size_t idx = row * DM + c0 + nt * 16 + l15; P.out[idx] = P.out[idx] + acc[mt][nt][r]; }
            }
    }
}

template <int EPI>
__device__ __forceinline__ void gemm_phase(const Params& P, const hf* A, const hf* Bt, int N, int K, char* smem) {
    const int tid = threadIdx.x, lane = tid & 63, w = tid >> 6;
    const int wm = w >> 2, wn = w & 3, l15 = lane & 15, g4 = lane >> 4;
    hf* sA = (hf*)smem;
    hf* sB = (hf*)(smem + 16384);
    const int tn = N / 256, nk = K / 32;
    const int srow = tid >> 2, sch = tid & 3;
    const int soff = srow * 32 + ((sch ^ fsw(srow)) * 8);
    const int roff = l15 * 32 + ((g4 ^ fsw(l15)) * 8);
    for (int it = 0;; ++it) {
        int pm, pn;
        if (gridDim.x == 256) { const int xcd = blockIdx.x & 7, slot = blockIdx.x >> 3, lt = slot + 32 * it; if (lt >= 16 * tn) break; pm = xcd * 16 + (lt & 15); pn = lt >> 4; }
        else { const int t = blockIdx.x + it * gridDim.x; if (t >= 128 * tn) break; pm = t & 127; pn = t >> 7; }
        if (EPI == EPI_IN1) {
            if (tid < 128) {
                const float* rowss = (const float*)(P.ws + WS_ROWSS) + (size_t)(pm * 128 + tid) * 16;
                float s = 0.f;
#pragma unroll
                for (int i = 0; i < 16; ++i) s += rowss[i];
                ((float*)(smem + 49152))[tid] = rsqrtf(s * (1.0f / 1024.0f) + 1e-6f);
            }
        }
        const hf* Ap = A + (size_t)(pm * 128 + srow) * K + sch * 8;
        const hf* Bp0 = Bt + (size_t)(pn * 256 + srow) * K + sch * 8;
        const hf* Bp1 = Bp0 + (size_t)128 * K;
        f4 acc[4][4];
#pragma unroll
        for (int i = 0; i < 4; ++i)
#pragma unroll
            for (int j = 0; j < 4; ++j) acc[i][j] = (f4){0.f, 0.f, 0.f, 0.f};
        h8 ra = *(const h8*)Ap, rb0 = *(const h8*)Bp0, rb1 = *(const h8*)Bp1;
        *(h8*)(sA + soff) = ra; *(h8*)(sB + soff) = rb0; *(h8*)(sB + 128 * 32 + soff) = rb1;
        __syncthreads();
        for (int kt = 0; kt < nk; ++kt) {
            const int cur = kt & 1;
            if (kt + 1 < nk) { ra = *(const h8*)(Ap + (kt + 1) * 32); rb0 = *(const h8*)(Bp0 + (kt + 1) * 32); rb1 = *(const h8*)(Bp1 + (kt + 1) * 32); }
            const hf* cA = sA + cur * 4096 + (wm * 64) * 32 + roff;
            const hf* cB = sB + cur * 8192 + (wn * 64) * 32 + roff;
            h8 af[4], bf[4];
#pragma unroll
            for (int i = 0; i < 4; ++i) { af[i] = *(const h8*)(cA + i * 16 * 32); bf[i] = *(const h8*)(cB + i * 16 * 32); }
#pragma unroll
            for (int i = 0; i < 4; ++i)
#pragma unroll
                for (int j = 0; j < 4; ++j) acc[i][j] = __builtin_amdgcn_mfma_f32_16x16x32_f16(af[i], bf[j], acc[i][j], 0, 0, 0);
            if (kt + 1 < nk) {
                const int nx = cur ^ 1;
                *(h8*)(sA + nx * 4096 + soff) = ra; *(h8*)(sB + nx * 8192 + soff) = rb0; *(h8*)(sB + nx * 8192 + 128 * 32 + soff) = rb1;
            }
            __syncthreads();
        }
        gemm_epilogue<EPI>(P, acc, pm, pn, wm, wn, lane, smem);
        __syncthreads();
    }
}

__device__ __forceinline__ void swa_item(const Params& P, int item, char* smem) {
    const int tid = threadIdx.x, lane = tid & 63, w = tid >> 6, l15 = lane & 15, g4 = lane >> 4;
    unsigned char* ws = P.ws;
    const int kv = item & 1, n = (item >> 1) & 63, b = item >> 7;
    const hf* z0 = (const hf*)(ws + WS_RB);
    const hf* v0t = (const hf*)(ws + WS_V0T);
    hf* cat = (hf*)(ws + WS_RA);
    hf* sK = (hf*)smem;
    hf* sVt = (hf*)(smem + 32768);
    float* sBias = (float*)(smem + 32768 + 33792);
    constexpr int VST = 264;
    const int tok0 = b * SEQ + n * 128;
    for (int i = tid; i < 256 * 8; i += NTHR) {
        const int j = i >> 3, ch = i & 7;
        h8 v = (h8){0, 0, 0, 0, 0, 0, 0, 0};
        if (n > 0 || j >= 128) v = *(const h8*)(z0 + (size_t)(tok0 - 128 + j) * N0 + 512 + kv * 64 + ch * 8);
        *(h8*)(sK + j * 64 + ((ch ^ (j & 7)) * 8)) = v;
    }
    for (int i = tid; i < 64 * 32; i += NTHR) {
        const int d = i >> 5, ch = i & 31;
        h8 v = (h8){0, 0, 0, 0, 0, 0, 0, 0};
        if (n > 0 || ch >= 16) v = *(const h8*)(v0t + (size_t)(b * 128 + kv * 64 + d) * SEQ + (n * 128 - 128 + ch * 8));
        *(h8*)(sVt + d * VST + ch * 8) = v;
    }
    {
        const float* b0 = (const float*)(ws + WS_TAB + TAB_BIAS0);
        sBias[tid] = b0[(kv * 4 + (tid >> 7)) * 128 + (tid & 127)];
    }
    __syncthreads();
    const int g = w >> 1, th = w & 1, h = kv * 4 + g;
    const float sink = P.in[7][h];
    for (int tt = 0; tt < 4; ++tt) {
        const int i0 = th * 64 + tt * 16;
        const int tokrow = tok0 + i0 + l15;
        h8 qf[2];
#pragma unroll
        for (int ks = 0; ks < 2; ++ks) qf[ks] = *(const h8*)(z0 + (size_t)tokrow * N0 + h * 64 + ks * 32 + g4 * 8);
        f4 s[9];
        const int jt0 = i0 >> 4;
#pragma unroll
        for (int c = 0; c < 9; ++c) {
            s[c] = (f4){0.f, 0.f, 0.f, 0.f};
            const int key = (jt0 + c) * 16 + l15;
#pragma unroll
            for (int ks = 0; ks < 2; ++ks) {
                const h8 kf = *(const h8*)(sK + key * 64 + (((ks * 4 + g4) ^ (key & 7)) * 8));
                s[c] = __builtin_amdgcn_mfma_f32_16x16x32_f16(kf, qf[ks], s[c], 0, 0, 0);
            }
        }
        const int i = i0 + l15;
        float m = sink;
#pragma unroll
        for (int c = 0; c < 9; ++c)
#pragma unroll
            for (int r = 0; r < 4; ++r) {
                const int j = (jt0 + c) * 16 + 4 * g4 + r;
                const int d = i + 128 - j;
                const bool valid = (d >= 0) && (d < 128) && (n > 0 || j >= 128);
                const float lg = valid ? (s[c][r] * 0.125f + sBias[g * 128 + (d & 127)]) : -1e30f;
                s[c][r] = lg; m = fmaxf(m, lg);
            }
        m = fmaxf(m, __shfl_xor(m, 16)); m = fmaxf(m, __shfl_xor(m, 32));
        float sum = 0.f;
#pragma unroll
        for (int c = 0; c < 9; ++c)
#pragma unroll
            for (int r = 0; r < 4; ++r) { const float p = (s[c][r] > -1e29f) ? __expf(s[c][r] - m) : 0.f; s[c][r] = p; sum += p; }
        sum += __shfl_xor(sum, 16); sum += __shfl_xor(sum, 32);
        sum += __expf(sink - m);
        const float inv = 1.0f / sum;
        f4 o[4];
#pragma unroll
        for (int mt = 0; mt < 4; ++mt) o[mt] = (f4){0.f, 0.f, 0.f, 0.f};
#pragma unroll
        for (int k2 = 0; k2 < 5; ++k2) {
            const int ca = 2 * k2, cb = 2 * k2 + 1;
            h8 pf;
#pragma unroll
            for (int r = 0; r < 4; ++r) { pf[r] = (hf)s[ca][r]; pf[4 + r] = (cb < 9) ? (hf)s[cb][r] : (hf)0; }
#pragma unroll
            for (int mt = 0; mt < 4; ++mt) {
                const int d = mt * 16 + l15;
                const h4 va = *(const h4*)(sVt + d * VST + (jt0 + ca) * 16 + 4 * g4);
                h4 vb = (h4){0, 0, 0, 0};
                if (cb < 9) vb = *(const h4*)(sVt + d * VST + (jt0 + cb) * 16 + 4 * g4);
                h8 vf; vf[0] = va[0]; vf[1] = va[1]; vf[2] = va[2]; vf[3] = va[3]; vf[4] = vb[0]; vf[5] = vb[1]; vf[6] = vb[2]; vf[7] = vb[3];
                o[mt] = __builtin_amdgcn_mfma_f32_16x16x32_f16(vf, pf, o[mt], 0, 0, 0);
            }
        }
#pragma unroll
        for (int mt = 0; mt < 4; ++mt) {
            const int dcol = h * 64 + mt * 16 + 4 * g4;
            const h4 sg = *(const h4*)(z0 + (size_t)tokrow * N0 + 768 + dcol);
            h4 ov;
#pragma unroll
            for (int r = 0; r < 4; ++r) ov[r] = (hf)(o[mt][r] * inv * (float)sg[r]);
            *(h4*)(cat + (size_t)tokrow * DM + dcol) = ov;
        }
    }
    __syncthreads();
}

template <int MODE>
__device__ __forceinline__ void ssm_item(const Params& P, int item, char* smem) {
    const int tid = threadIdx.x, lane = tid & 63, w = tid >> 6, l15 = lane & 15, g4 = lane >> 4;
    unsigned char* ws = P.ws;
    const int b = item >> 7, c = item & 127;
    const hf* z0 = (const hf*)(ws + WS_RB);
    float* S = (float*)(ws + WS_SC);
    hf* yg = (hf*)(ws + WS_RC);
    float* sBU = (float*)(smem + w * 12800);
    hf* sX = (hf*)(smem + w * 12800 + 8192);
    const float* tab_ab = (const float*)(ws + WS_TAB + TAB_AB);
    const float* tab_at = (const float*)(ws + WS_TAB + TAB_AT);
    const float* tab_dt = (const float*)(ws + WS_TAB + TAB_DT);
    const hf* bbs = (const hf*)(ws + WS_TAB + TAB_BBS);
    const hf* cri = (const hf*)(ws + WS_TAB + TAB_CRI);
    const int tokc = b * SEQ + c * 64;
    float cr[4], ci[4];
#pragma unroll
    for (int q = 0; q < 4; ++q) { cr[q] = 0.f; ci[q] = 0.f; }
    if (MODE == 1) {
        float atr[4], ati[4];
#pragma unroll
        for (int q = 0; q < 4; ++q) { const int g = w * 4 + q; atr[q] = tab_at[(g * 64 + lane) * 2]; ati[q] = tab_at[(g * 64 + lane) * 2 + 1]; }
        const float* Sb = S + (size_t)b * 128 * 4096 + (w * 4) * 128 + lane;
#pragma unroll 4
        for (int cc = 0; cc < c; ++cc) {
            float sr[4], si[4];
#pragma unroll
            for (int q = 0; q < 4; ++q) { sr[q] = Sb[(size_t)cc * 4096 + q * 128]; si[q] = Sb[(size_t)cc * 4096 + q * 128 + 64]; }
#pragma unroll
            for (int q = 0; q < 4; ++q) {
                const float nr = atr[q] * cr[q] - ati[q] * ci[q] + sr[q];
                const float ni = atr[q] * ci[q] + ati[q] * cr[q] + si[q];
                cr[q] = nr; ci[q] = ni;
            }
        }
    }
    for (int q = 0; q < 4; ++q) {
        const int g = w * 4 + q;
        const float abr = tab_ab[(g * 64 + lane) * 2], abi = tab_ab[(g * 64 + lane) * 2 + 1];
        h4 bf[8];
#pragma unroll
        for (int nt = 0; nt < 8; ++nt) bf[nt] = *(const h4*)(bbs + ((size_t)g * 128 + nt * 16 + l15) * 16 + 4 * g4);
        h8 cf[4];
        float dtg = 0.f, dsk = 0.f;
        if (MODE == 1) {
#pragma unroll
            for (int ks = 0; ks < 4; ++ks) cf[ks] = *(const h8*)(cri + ((size_t)g * 16 + l15) * 128 + ks * 32 + g4 * 8);
            dtg = tab_dt[g]; dsk = P.in[15][g * 16 + l15];
        }
        float xr = 0.f, xi = 0.f;
        if (MODE == 1) { xr = (q == 0) ? cr[0] : (q == 1) ? cr[1] : (q == 2) ? cr[2] : cr[3]; xi = (q == 0) ? ci[0] : (q == 1) ? ci[1] : (q == 2) ? ci[2] : ci[3]; }
        for (int mt = 0; mt < 4; ++mt) {
            const int tokm = tokc + mt * 16;
            const h4 uf = *(const h4*)(z0 + (size_t)(tokm + l15) * N0 + 1280 + g * 16 + 4 * g4);
#pragma unroll
            for (int nt = 0; nt < 8; ++nt) {
                f4 d = (f4){0.f, 0.f, 0.f, 0.f};
                d = __builtin_amdgcn_mfma_f32_16x16x16f16(uf, bf[nt], d, 0, 0, 0);
#pragma unroll
                for (int r = 0; r < 4; ++r) sBU[(4 * g4 + r) * 128 + nt * 16 + l15] = d[r];
            }
            LDS_FENCE();
#pragma unroll
            for (int t = 0; t < 16; ++t) {
                const float bur = sBU[t * 128 + lane], bui = sBU[t * 128 + 64 + lane];
                const float nr = abr * xr - abi * xi + bur;
                const float ni = abr * xi + abi * xr + bui;
                xr = nr; xi = ni;
                if (MODE == 1) { sX[t * 136 + lane] = (hf)xr; sX[t * 136 + 64 + lane] = (hf)xi; }
            }
            LDS_FENCE();
            if (MODE == 1) {
                f4 y = (f4){0.f, 0.f, 0.f, 0.f};
#pragma unroll
                for (int ks = 0; ks < 4; ++ks) {
                    const h8 xf = *(const h8*)(sX + l15 * 136 + ks * 32 + g4 * 8);
                    y = __builtin_amdgcn_mfma_f32_16x16x32_f16(xf, cf[ks], y, 0, 0, 0);
                }
#pragma unroll
                for (int r = 0; r < 4; ++r) {
                    const size_t row = tokm + 4 * g4 + r;
                    const float u = (float)z0[row * N0 + 1280 + g * 16 + l15];
                    const float yv = dtg * y[r] + dsk * u;
                    yg[row * 512 + g * 16 + l15] = (hf)gelu_tanh_f(yv);
                }
                LDS_FENCE();
            }
        }
        if (MODE == 0) {
            float* Sd = S + ((size_t)(b * 128 + c) * 32 + g) * 128;
            Sd[lane] = xr; Sd[64 + lane] = xi;
        }
    }
}

constexpr int CAND_CAP = 128;

__device__ __forceinline__ void idx_scores(const h8 (&qf)[8][2], const float (&wv)[8], const hf* kib, int kt, int l15, int g4, float (&sc)[4]) {
    const hf* kp = kib + (size_t)(kt * 16 + l15) * 64 + g4 * 8;
    const h8 k0 = *(const h8*)kp, k1 = *(const h8*)(kp + 32);
    sc[0] = sc[1] = sc[2] = sc[3] = 0.f;
#pragma unroll
    for (int h = 0; h < 8; ++h) {
        f4 a = (f4){0.f, 0.f, 0.f, 0.f};
        a = __builtin_amdgcn_mfma_f32_16x16x32_f16(k0, qf[h][0], a, 0, 0, 0);
        a = __builtin_amdgcn_mfma_f32_16x16x32_f16(k1, qf[h][1], a, 0, 0, 0);
#pragma unroll
        for (int r = 0; r < 4; ++r) sc[r] = __builtin_fmaf(wv[h], fmaxf(a[r], 0.f), sc[r]);
    }
}
__device__ __forceinline__ int score_bin(float s) {
    const float t = __builtin_fmaf(s, 128.0f, 512.0f);
    int bi = (int)floorf(t);
    bi = bi < 0 ? 0 : (bi > 1023 ? 1023 : bi);
    return bi;
}

__device__ __forceinline__ void select_item(const Params& P, int b, int n32, char* smem) {
    const int tid = threadIdx.x, lane = tid & 63, w = tid >> 6, l15 = lane & 15, g4 = lane >> 4;
    unsigned char* ws = P.ws;
    const hf* qi = (const hf*)(ws + WS_RC);
    const hf* kib = (const hf*)(ws + WS_KI) + (size_t)b * SEQ * 64;
    const float* wi = (const float*)(ws + WS_WI);
    u16* lists = (u16*)(ws + WS_LIST);
    int* cnts = (int*)(ws + WS_CNT);
    u32* hist = (u32*)smem;
    u32* bitmap = (u32*)smem;
    float* cand_s = (float*)(smem + 32768);
    int* cand_i = (int*)(smem + 32768 + 16384);
    int* ccount = (int*)(smem + 65536);
    int* bstar = (int*)(smem + 65536 + 128);
    int* need = (int*)(smem + 65536 + 256);
    const int t0 = n32 * 32;
    const int qg = w >> 2, ksplit = w & 3;
    const int tq = t0 + qg * 16 + l15;
    const int ql = qg * 16 + l15;
    const size_t qrow = (size_t)b * SEQ + tq;
    h8 qf[8][2]; float wv[8];
#pragma unroll
    for (int h = 0; h < 8; ++h) {
        qf[h][0] = *(const h8*)(qi + qrow * 512 + h * 64 + g4 * 8);
        qf[h][1] = *(const h8*)(qi + qrow * 512 + h * 64 + 32 + g4 * 8);
        wv[h] = wi[qrow * 8 + h];
    }
    const int ktd = (t0 + qg * 16) >> 4;
    for (int i = tid; i < 16384; i += NTHR) hist[i] = 0u;
    __syncthreads();
    for (int kt = ksplit; kt <= ktd; kt += 4) {
        float sc[4];
        idx_scores(qf, wv, kib, kt, l15, g4, sc);
#pragma unroll
        for (int r = 0; r < 4; ++r) {
            const int key = kt * 16 + 4 * g4 + r;
            if (key <= tq) { const int bi = score_bin(sc[r]); atomicAdd(&hist[ql * 512 + (bi >> 1)], 1u << (16 * (bi & 1))); }
        }
    }
    __syncthreads();
    for (int qq = 0; qq < 4; ++qq) {
        const int q = w * 4 + qq, t = t0 + q;
        int bs = -1, nd = 0;
        if (t + 1 > 256) {
            u32 wd[8]; int tot = 0;
#pragma unroll
            for (int i = 0; i < 8; ++i) { wd[i] = hist[q * 512 + 504 - 8 * lane + i]; tot += (int)(wd[i] & 0xffffu) + (int)(wd[i] >> 16); }
            int pre = tot;
#pragma unroll
            for (int o = 1; o < 64; o <<= 1) { const int v = __shfl_up(pre, o); if (lane >= o) pre += v; }
            const int excl = pre - tot;
            const bool mine = (excl < 256) && (pre >= 256);
            if (mine) {
                int cum = excl; int found = -1, fneed = 0;
#pragma unroll
                for (int i = 7; i >= 0; --i) {
#pragma unroll
                    for (int hh = 1; hh >= 0; --hh) {
                        const int cntb = (int)((wd[i] >> (16 * hh)) & 0xffffu);
                        if (found < 0 && cum + cntb >= 256) { found = (504 - 8 * lane + i) * 2 + hh; fneed = 256 - cum; }
                        cum += cntb;
                    }
                }
                bstar[q] = found; need[q] = fneed;
            }
        } else if (lane == 0) { bstar[q] = bs; need[q] = nd; }
    }
    __syncthreads();
    for (int i = tid; i < 8192; i += NTHR) bitmap[i] = 0u;
    if (tid < 32) ccount[tid] = 0;
    __syncthreads();
    {
        const int bsq = bstar[ql];
        for (int kt = ksplit; kt <= ktd; kt += 4) {
            float sc[4];
            idx_scores(qf, wv, kib, kt, l15, g4, sc);
#pragma unroll
            for (int r = 0; r < 4; ++r) {
                const int key = kt * 16 + 4 * g4 + r;
                if (key <= tq) {
                    const int bi = score_bin(sc[r]);
                    if (bi > bsq) atomicOr(&bitmap[ql * 256 + (key >> 5)], 1u << (key & 31));
                    else if (bi == bsq) { const int pos = atomicAdd(&ccount[ql], 1); if (pos < CAND_CAP) { cand_s[ql * CAND_CAP + pos] = sc[r]; cand_i[ql * CAND_CAP + pos] = key; } }
                }
            }
        }
    }
    __syncthreads();
    for (int qq = 0; qq < 4; ++qq) {
        const int q = w * 4 + qq, t = t0 + q;
        const int nc = min(ccount[q], CAND_CAP), nd = need[q];
        for (int i = lane; i < nc; i += 64) {
            const float si = cand_s[q * CAND_CAP + i]; const int ii = cand_i[q * CAND_CAP + i];
            int rank = 0;
            for (int j = 0; j < nc; ++j) { const float sj = cand_s[q * CAND_CAP + j]; const int ij = cand_i[q * CAND_CAP + j]; rank += (sj > si || (sj == si && ij < ii)) ? 1 : 0; }
            if (rank < nd) atomicOr(&bitmap[q * 256 + (ii >> 5)], 1u << (ii & 31));
        }
        LDS_FENCE();
        u32 wd[4]; int tot = 0;
#pragma unroll
        for (int i = 0; i < 4; ++i) { wd[i] = bitmap[q * 256 + lane * 4 + i]; tot += __popc(wd[i]); }
        int pre = tot;
#pragma unroll
        for (int o = 1; o < 64; o <<= 1) { const int v = __shfl_up(pre, o); if (lane >= o) pre += v; }
        int pos = pre - tot;
        u16* lp = lists + ((size_t)b * SEQ + t) * 256;
#pragma unroll
        for (int i = 0; i < 4; ++i) {
            u32 x = wd[i];
            while (x) { const int bit = __ffs(x) - 1; x &= x - 1; if (pos < 256) lp[pos] = (u16)((lane * 4 + i) * 32 + bit); ++pos; }
        }
        const int total = __shfl(pre, 63);
        if (lane == 0) cnts[(size_t)b * SEQ + t] = min(total, 256);
    }
    __syncthreads();
}

__device__ __forceinline__ void dsa_attn_phase(const Params& P, char* smem) {
    const int tid = threadIdx.x, lane = tid & 63, w = tid >> 6, l15 = lane & 15, g4 = lane >> 4;
    unsigned char* ws = P.ws;
    const hf* q1 = (const hf*)(ws + WS_RA);
    const hf* k1 = (const hf*)(ws + WS_RB + 64 * MiB);
    const hf* v1 = (const hf*)(ws + WS_V1);
    const hf* sg1 = (const hf*)(ws + WS_RB + 32 * MiB);
    hf* att = (hf*)(ws + WS_RB);
    const u16* lists = (const u16*)(ws + WS_LIST);
    const int* cnts = (const int*)(ws + WS_CNT);
    unsigned char* sBkt = (unsigned char*)smem;
    float* sRb = (float*)(smem + 8192);
    constexpr int VST = 136;
    hf* sV = (hf*)(smem + 9216 + w * 9728);
    u16* sL = (u16*)(smem + 9216 + w * 9728 + 8704);
    for (int i = tid; i < 2048; i += NTHR) ((u32*)sBkt)[i] = ((const u32*)(ws + WS_TAB + TAB_BKT))[i];
    if (tid < 256) sRb[tid] = P.in[1][tid];
    __syncthreads();
    const int G = gridDim.x;
    const int xg = blockIdx.x & 7;
    const int nbg = (G - xg + 7) / 8;
    const int b = xg >> 2, kv = (xg >> 1) & 1, half = xg & 1;
    const int rank = (blockIdx.x >> 3) * 8 + w;
    const int n = l15;
    const int h = kv * 4 + (n & 3);
    for (int i = rank; i < 4096; i += nbg * 8) {
        const int t = 2 * i + half;
        const size_t row = (size_t)b * SEQ + t;
        const int cnt = cnts[row];
        {
            const u16* lp = lists + row * 256;
#pragma unroll
            for (int j = 0; j < 4; ++j) { const int s = lane * 4 + j; sL[s] = (s < cnt) ? lp[s] : (u16)0; }
        }
        LDS_FENCE();
        h8 qf[4];
#pragma unroll
        for (int ks = 0; ks < 4; ++ks) {
            qf[ks] = (h8){0, 0, 0, 0, 0, 0, 0, 0};
            if (n < 4) qf[ks] = *(const h8*)(q1 + row * 1024 + h * 128 + ks * 32 + g4 * 8);
        }
        f4 s[16];
#pragma unroll
        for (int c = 0; c < 16; ++c) {
            s[c] = (f4){0.f, 0.f, 0.f, 0.f};
            const int idx = sL[c * 16 + l15];
            const hf* kp = k1 + ((size_t)b * SEQ + idx) * 256 + kv * 128 + g4 * 8;
#pragma unroll
            for (int ks = 0; ks < 4; ++ks) {
                const h8 kf = *(const h8*)(kp + ks * 32);
                s[c] = __builtin_amdgcn_mfma_f32_16x16x32_f16(kf, qf[ks], s[c], 0, 0, 0);
            }
        }
        float m = -1e30f;
#pragma unroll
        for (int c = 0; c < 16; ++c) {
            const int sl0 = c * 16 + 4 * g4;
#pragma unroll
            for (int r = 0; r < 4; ++r) {
                const int sl = sl0 + r;
                const int idx = sL[sl];
                const int d = t - idx;
                const bool valid = (sl < cnt) && (d >= 0);
                const int bk = sBkt[valid ? d : 0];
                const float lg = valid ? (s[c][r] * 0.08838834764831845f + sRb[bk * 8 + h]) : -1e30f;
                s[c][r] = lg; m = fmaxf(m, lg);
            }
        }
        m = fmaxf(m, __shfl_xor(m, 16)); m = fmaxf(m, __shfl_xor(m, 32));
        float sum = 0.f;
#pragma unroll
        for (int c = 0; c < 16; ++c)
#pragma unroll
            for (int r = 0; r < 4; ++r) { const float p = (s[c][r] > -1e29f) ? __expf(s[c][r] - m) : 0.f; s[c][r] = p; sum += p; }
        sum += __shfl_xor(sum, 16); sum += __shfl_xor(sum, 32);
        const float inv = 1.0f / sum;
        f4 o[8];
#pragma unroll
        for (int mt = 0; mt < 8; ++mt) o[mt] = (f4){0.f, 0.f, 0.f, 0.f};
#pragma unroll
        for (int k2 = 0; k2 < 8; ++k2) {
#pragma unroll
            for (int j = 0; j < 8; ++j) {
                const int rr = j * 4 + g4;
                const int idx = sL[k2 * 32 + rr];
                const h8 v = *(const h8*)(v1 + ((size_t)b * SEQ + idx) * 256 + kv * 128 + l15 * 8);
                *(h8*)(sV + rr * VST + l15 * 8) = v;
            }
            LDS_FENCE();
            h8 pf;
#pragma unroll
            for (int r = 0; r < 4; ++r) { pf[r] = (hf)s[2 * k2][r]; pf[4 + r] = (hf)s[2 * k2 + 1][r]; }
            const int q4 = l15 >> 2, p4 = l15 & 3;
#pragma unroll
            for (int mt = 0; mt < 8; ++mt) {
                const fp16x4_t lo = __builtin_amdgcn_ds_read_tr16_b64_v4f16((LAS fp16x4_t*)(sV + (4 * g4 + q4) * VST + mt * 16 + 4 * p4));
                const fp16x4_t hi = __builtin_amdgcn_ds_read_tr16_b64_v4f16((LAS fp16x4_t*)(sV + (16 + 4 * g4 + q4) * VST + mt * 16 + 4 * p4));
                const h4 l4 = __builtin_bit_cast(h4, lo), h4v = __builtin_bit_cast(h4, hi);
                h8 vf; vf[0] = l4[0]; vf[1] = l4[1]; vf[2] = l4[2]; vf[3] = l4[3]; vf[4] = h4v[0]; vf[5] = h4v[1]; vf[6] = h4v[2]; vf[7] = h4v[3];
                o[mt] = __builtin_amdgcn_mfma_f32_16x16x32_f16(vf, pf, o[mt], 0, 0, 0);
            }
            LDS_FENCE();
        }
        if (n < 4) {
#pragma unroll
            for (int mt = 0; mt < 8; ++mt) {
                const int dcol = h * 128 + mt * 16 + 4 * g4;
                const h4 sg = *(const h4*)(sg1 + row * 1024 + dcol);
                h4 ov;
#pragma unroll
                for (int r = 0; r < 4; ++r) ov[r] = (hf)(o[mt][r] * inv * (float)sg[r]);
                *(h4*)(att + row * 1024 + dcol) = ov;
            }
        }
    }
    __syncthreads();
}

__global__ void __launch_bounds__(NTHR, 2) mega_fwd(Params P) {
    extern __shared__ __attribute__((aligned(16))) char smem[];
    unsigned char* ws = P.ws;
    const int lo = P.ph_lo, hi = P.ph_hi;
#if ONE_LAUNCH
    volatile LAS unsigned* st = (volatile LAS unsigned*)(smem + LDS_BYTES - 16);
    if (threadIdx.x == 0) { st[0] = 0u; st[1] = 0u; }
    __syncthreads();
    XcdBarrier bar = xcd_barrier_post((unsigned*)(ws + WS_BAR), st);
#define GRID_BAR() xcd_barrier(bar)
#else
#define GRID_BAR() do {} while (0)
#endif
#define IN(k) (lo <= (k) && (k) < hi)
#define SEAM(k) do { if (IN(k) && IN((k) + 1)) GRID_BAR(); } while (0)
    if (IN(0)) { p0_prep(P, smem); } SEAM(0);
    if (IN(1)) { gemm_phase<EPI_IN0>(P, (const hf*)(ws + WS_RA), (const hf*)(ws + WS_WT_IN0), N0, 1024, smem); } SEAM(1);
    if (IN(2)) {
        for (int it = blockIdx.x; it < 256; it += gridDim.x) swa_item(P, it, smem);
        for (int it = blockIdx.x; it < 256; it += gridDim.x) ssm_item<0>(P, it, smem);
    } SEAM(2);
    if (IN(3)) { for (int it = blockIdx.x; it < 256; it += gridDim.x) ssm_item<1>(P, it, smem); } SEAM(3);
    if (IN(4)) { gemm_phase<EPI_GLU>(P, (const hf*)(ws + WS_RC), (const hf*)(ws + WS_WT_GLU), 1024, 512, smem); } SEAM(4);
    if (IN(5)) { gemm_phase<EPI_OUT0>(P, (const hf*)(ws + WS_RA), (const hf*)(ws + WS_WT_OUT0), 1024, 1024, smem); } SEAM(5);
    if (IN(6)) { gemm_phase<EPI_IN1>(P, (const hf*)(ws + WS_RB), (const hf*)(ws + WS_WT_IN1), N1P, 1024, smem); } SEAM(6);
    if (IN(7)) {
        for (int pr = blockIdx.x; pr < 256; pr += gridDim.x) {
            const int b = pr & 1, j = pr >> 1;
            select_item(P, b, 255 - j, smem);
            select_item(P, b, j, smem);
        }
    } SEAM(7);
    if (IN(8)) { dsa_attn_phase(P, smem); } SEAM(8);
    if (IN(9)) { gemm_phase<EPI_OUT1>(P, (const hf*)(ws + WS_RB), (const hf*)(ws + WS_WT_OUT1), 1024, 1024, smem); }
}

extern "C" void kernel_launch(void* const* d_in, const int* in_sizes, int n_in, void* d_out, int out_size, void* d_ws, size_t ws_size, hipStream_t stream) {
    static int grid = 0;
    if (grid == 0) {
        int dev = 0, cus = 0;
        if (n_in != 22 || out_size != MTOK * DM || ws_size < WS_END) { fprintf(stderr, "kernel_launch: unexpected shapes (n_in %d out %d ws %zu need %zu)\n", n_in, out_size, ws_size, (size_t)WS_END); grid = -1; return; }
        if (hipGetDevice(&dev) != hipSuccess || hipDeviceGetAttribute(&cus, hipDeviceAttributeMultiprocessorCount, dev) != hipSuccess) { grid = -1; return; }
        if (hipFuncSetAttribute((const void*)mega_fwd, hipFuncAttributeMaxDynamicSharedMemorySize, LDS_BYTES) != hipSuccess) { fprintf(stderr, "kernel_launch: hipFuncSetAttribute failed\n"); grid = -1; return; }
        grid = cus;
        if (grid < 8) grid = 8;
    }
    if (grid < 0) return;
    Params p{};
    for (int i = 0; i < 22; ++i) p.in[i] = (const float*)d_in[i];
    p.out = (float*)d_out; p.ws = (unsigned char*)d_ws;
#if ONE_LAUNCH
    (void)hipMemsetAsync((char*)d_ws + WS_BAR, 0, XCD_BAR_WORDS * 4, stream);
    p.ph_lo = 0; p.ph_hi = NPHASE;
    hipLaunchKernelGGL(mega_fwd, dim3(grid), dim3(NTHR), LDS_BYTES, stream, p);
#else
    for (int ph = 0; ph < NPHASE; ++ph) {
        p.ph_lo = ph; p.ph_hi = ph + 1;
        hipLaunchKernelGGL(mega_fwd, dim3(grid), dim3(NTHR), LDS_BYTES, stream, p);
    }
#endif
}
```

```cpp
#include <hip/hip_runtime.h>
#include <stdint.h>
#include <stdio.h>

#ifndef REP_PHASE
#define REP_PHASE -1
#define REP_N 0
#endif
#ifndef SEL_REP_A
#define SEL_REP_A 0
#define SEL_REP_B 0
#define SEL_REP_C 0
#endif
#ifndef ONE_LAUNCH
#define ONE_LAUNCH 1
#endif

typedef _Float16 hf;
typedef _Float16 h8 __attribute__((ext_vector_type(8)));
typedef _Float16 h4 __attribute__((ext_vector_type(4)));
typedef _Float16 h2 __attribute__((ext_vector_type(2)));
typedef float f4 __attribute__((ext_vector_type(4)));
typedef unsigned u32;
typedef unsigned short u16;
typedef long l2 __attribute__((ext_vector_type(2)));
typedef __fp16 fp16x4_t __attribute__((__vector_size__(4 * sizeof(__fp16))));
#define LAS __attribute__((address_space(3)))

constexpr int NTHR = 512;
constexpr int SEQ = 8192, DM = 1024, MTOK = 2 * SEQ;
constexpr int N0 = 2304, N1 = 3144, N1P = 3328;
constexpr int NPHASE = 10;
constexpr int LDS_BYTES = 144 * 1024;

constexpr size_t MiB = 1024 * 1024;
constexpr size_t WS_BAR    = 0;
constexpr size_t WS_WT_IN0 = 64 * 1024;
constexpr size_t WS_WT_OUT0 = WS_WT_IN0 + (size_t)N0 * 1024 * 2;
constexpr size_t WS_WT_GLU = WS_WT_OUT0 + (size_t)1024 * 1024 * 2;
constexpr size_t WS_WT_IN1 = WS_WT_GLU + (size_t)1024 * 512 * 2;
constexpr size_t WS_WT_OUT1 = WS_WT_IN1 + (size_t)N1P * 1024 * 2;
constexpr size_t WS_TAB    = WS_WT_OUT1 + (size_t)1024 * 1024 * 2;
constexpr size_t TAB_AB   = 0;
constexpr size_t TAB_AT   = 16384;
constexpr size_t TAB_DT   = 32768;
constexpr size_t TAB_BBS  = 33792;
constexpr size_t TAB_CRI  = TAB_BBS + 131072;
constexpr size_t TAB_BIAS0 = TAB_CRI + 131072;
constexpr size_t TAB_BKT  = TAB_BIAS0 + 4096;
constexpr size_t TAB_SIZE = 512 * 1024;
constexpr size_t WS_RA = 18 * MiB;
constexpr size_t WS_RB = WS_RA + 32 * MiB;
constexpr size_t WS_RC = WS_RB + 72 * MiB;
constexpr size_t WS_V1 = WS_RC + 16 * MiB;
constexpr size_t WS_KI = WS_V1 + 8 * MiB;
constexpr size_t WS_WI = WS_KI + 2 * MiB;
constexpr size_t WS_LIST = WS_WI + MiB;
constexpr size_t WS_CNT = WS_LIST + 8 * MiB;
constexpr size_t WS_SC = WS_CNT + MiB;
constexpr size_t WS_V0T = WS_SC + 4 * MiB;
constexpr size_t WS_ROWSS = WS_V0T + 4 * MiB;
constexpr size_t WS_CIN = WS_ROWSS + MiB;
constexpr size_t WS_H1 = WS_CIN + 4 * MiB;
constexpr size_t WS_END = WS_H1 + 32 * MiB;

struct Params {
    const float* in[22];
    float* out;
    unsigned char* ws;
    int ph_lo, ph_hi;
};

__device__ __forceinline__ float silu_f(float x) { return x / (1.0f + __expf(-x)); }
__device__ __forceinline__ float sigmoid_f(float x) { return 1.0f / (1.0f + __expf(-x)); }
__device__ __forceinline__ float gelu_tanh_f(float x) {
    const float z = 0.7978845608028654f * (x + 0.044715f * x * x * x);
    const float e = __expf(2.0f * z);
    const float th = 1.0f - 2.0f / (e + 1.0f);
    return 0.5f * x * (1.0f + th);
}
__device__ __forceinline__ float red16(float v) {
    v += __shfl_xor(v, 1); v += __shfl_xor(v, 2); v += __shfl_xor(v, 4); v += __shfl_xor(v, 8); return v;
}
__device__ __forceinline__ unsigned char f2fp8(float v) { return (unsigned char)(__builtin_amdgcn_cvt_pk_fp8_f32(v, v, 0, false) & 0xff); }
__device__ __forceinline__ int fsw(int row) { return (0x78 >> (((row >> 2) & 3) * 2)) & 3; }
#define LDS_FENCE() asm volatile("s_waitcnt lgkmcnt(0)" ::: "memory")
#define WAVE_ORDER() asm volatile("" ::: "memory")

#define XB_TMO      128
#define XB_XCNT(j)  (256  + 64 * (j))
#define XB_XSUB(j)  (1280 + 64 * (j))
#define XB_XGEN(j)  (2304 + 64 * (j))
#define XB_TOP      3328
#define XB_TOPGEN   3392
#define XCD_BAR_WORDS 3456
#define XB_SPIN_CAP (1u << 22)
__device__ __forceinline__ unsigned xb_ld(unsigned* p)              { return __hip_atomic_load(p, __ATOMIC_RELAXED, __HIP_MEMORY_SCOPE_AGENT); }
__device__ __forceinline__ unsigned xb_add(unsigned* p, unsigned v) { return __hip_atomic_fetch_add(p, v, __ATOMIC_RELAXED, __HIP_MEMORY_SCOPE_AGENT); }
__device__ __forceinline__ unsigned xb_xcc_id() { return (unsigned)__builtin_amdgcn_s_getreg((3 << 11) | 20) & 0xFu; }
#define XB_SPIN(cond, bar) do { unsigned _sp = 0; while (cond) { __builtin_amdgcn_s_sleep(1); \
    if ((++_sp & 255u) == 0u) { if (xb_ld(&(bar)[XB_TMO])) break; if (_sp > XB_SPIN_CAP) { atomicAdd(&(bar)[XB_TMO], 1u); break; } } } } while (0)
struct XcdBarrier { unsigned* bar; unsigned x; volatile LAS unsigned* st; };
__device__ __forceinline__ XcdBarrier xcd_barrier_post(unsigned* bar, volatile LAS unsigned* st) {
    XcdBarrier b; b.bar = bar; b.x = xb_xcc_id(); b.st = st;
    if (threadIdx.x == 0) (void)xb_add(&bar[XB_XCNT(b.x)], 1u);
    return b;
}
__device__ __forceinline__ void xcd_barrier_complete(unsigned* bar, unsigned x, unsigned& nloc, unsigned& nx) {
    const unsigned G = gridDim.x;
    unsigned sum, cnt, mine, sp = 0u;
    for (;;) {
        sum = 0u; cnt = 0u; mine = 0u;
#pragma unroll
        for (unsigned j = 0; j < 16; ++j) { const unsigned c = xb_ld(&bar[XB_XCNT(j)]); sum += c; cnt += (c > 0u) ? 1u : 0u; mine = (j == x) ? c : mine; }
        if (sum == G) break;
        __builtin_amdgcn_s_sleep(1);
        if ((++sp & 255u) == 0u) { if (xb_ld(&bar[XB_TMO])) break; if (sp > XB_SPIN_CAP) { atomicAdd(&bar[XB_TMO], 1u); break; } }
    }
    nloc = mine > 0u ? mine : 1u; nx = cnt > 0u ? cnt : 1u;
}
__device__ __forceinline__ void xcd_barrier(const XcdBarrier& b) {
    asm volatile("s_waitcnt vmcnt(0)" ::: "memory");
    __syncthreads();
    if (threadIdx.x == 0) {
        unsigned* bar = b.bar;
        __builtin_amdgcn_s_waitcnt(0);
        unsigned nloc = b.st[0], nx = b.st[1];
        if (nloc == 0u) { xcd_barrier_complete(bar, b.x, nloc, nx); b.st[0] = nloc; b.st[1] = nx; }
        const unsigned old = xb_add(&bar[XB_XSUB(b.x)], 1u);
        const unsigned gen = old / nloc;
        if (old + 1u == (gen + 1u) * nloc) {
            __builtin_amdgcn_fence(__ATOMIC_RELEASE, "agent");
            asm volatile("s_waitcnt vmcnt(0)" ::: "memory");
            const unsigned og = xb_add(&bar[XB_TOP], 1u);
            const unsigned tg = og / nx;
            if (og + 1u == (tg + 1u) * nx) xb_add(&bar[XB_TOPGEN], 1u);
            else XB_SPIN(xb_ld(&bar[XB_TOPGEN]) == tg, bar);
            __builtin_amdgcn_fence(__ATOMIC_ACQUIRE, "agent");
            xb_add(&bar[XB_XGEN(b.x)], 1u);
            asm volatile("s_waitcnt vmcnt(0)" ::: "memory");
        } else {
            XB_SPIN(xb_ld(&bar[XB_XGEN(b.x)]) == gen, bar);
            __builtin_amdgcn_fence(__ATOMIC_ACQUIRE, "agent");
            asm volatile("s_waitcnt vmcnt(0)" ::: "memory");
        }
    }
    __syncthreads();
}

__device__ __forceinline__ void transpose_tile(const float* __restrict__ src, int K, int N, hf* dst, int k0, int n0, int mode, float* tile, const float* __restrict__ ks) {
    const int tid = threadIdx.x;
#pragma unroll
    for (int i = 0; i < 8; ++i) {
        const int kk = (tid >> 6) + 8 * i, nn = tid & 63, n = n0 + nn;
        const float sk = ks ? ks[k0 + kk] : 1.0f;
        tile[kk * 65 + nn] = (n < N) ? src[(size_t)(k0 + kk) * N + n] * sk : 0.0f;
    }
    __syncthreads();
    {
        const int nn = tid >> 3, kc = tid & 7, n = n0 + nn;
        int drow = n;
        if (mode == 1) { const int j = n & 511, half = n >> 9; drow = (j >> 2) * 8 + half * 4 + (j & 3); }
        if (mode == 2) { drow = (n < 512) ? n : ((n < 768) ? (n + 1536) : (n - 256)); }
        h8 v;
#pragma unroll
        for (int j = 0; j < 8; ++j) v[j] = (hf)tile[(kc * 8 + j) * 65 + nn];
        *(h8*)(dst + (size_t)drow * K + k0 + kc * 8) = v;
    }
    __syncthreads();
}

__device__ __forceinline__ void transpose_range(const Params& P, char* smem, int lo, int hi) {
    unsigned char* ws = P.ws;
    for (int it = lo + blockIdx.x; it < hi; it += gridDim.x) {
        const float* src; hf* dst; int K, N, ntl, mode = 0, loc; const float* ks = nullptr;
        if (it < 576)       { loc = it;        src = P.in[3];  dst = (hf*)(ws + WS_WT_IN0);  K = 1024; N = N0;   ntl = 36; mode = 2; }
        else if (it < 832)  { loc = it - 576;  src = P.in[4];  dst = (hf*)(ws + WS_WT_OUT0); K = 1024; N = 1024; ntl = 16; }
        else if (it < 960)  { loc = it - 832;  src = P.in[16]; dst = (hf*)(ws + WS_WT_GLU);  K = 512;  N = 1024; ntl = 16; mode = 1; }
        else if (it < 1792) { loc = it - 960;  src = P.in[18]; dst = (hf*)(ws + WS_WT_IN1);  K = 1024; N = N1;   ntl = 52; ks = P.in[2] + DM; }
        else                { loc = it - 1792; src = P.in[19]; dst = (hf*)(ws + WS_WT_OUT1); K = 1024; N = 1024; ntl = 16; }
        const int kt = loc / ntl, nt = loc % ntl;
        transpose_tile(src, K, N, dst, kt * 64, nt * 64, mode, (float*)smem, ks);
    }
}

__device__ __forceinline__ void p0_prep(const Params& P, char* smem) {
    const int tid = threadIdx.x, lane = tid & 63, w = tid >> 6;
    unsigned char* ws = P.ws;
    transpose_range(P, smem, 0, 576);
    {
        const float* x = P.in[0]; const float* g = P.in[2];
        hf* hn0 = (hf*)(ws + WS_RA);
        f4 gv[4];
#pragma unroll
        for (int i = 0; i < 4; ++i) gv[i] = *(const f4*)(g + i * 256 + lane * 4);
        for (int row = blockIdx.x * 8 + w; row < MTOK; row += gridDim.x * 8) {
            f4 v[4]; float ss = 0.f;
#pragma unroll
            for (int i = 0; i < 4; ++i) { v[i] = *(const f4*)(x + (size_t)row * DM + i * 256 + lane * 4); ss += v[i][0] * v[i][0] + v[i][1] * v[i][1] + v[i][2] * v[i][2] + v[i][3] * v[i][3]; }
#pragma unroll
            for (int o = 1; o < 64; o <<= 1) ss += __shfl_xor(ss, o);
            const float rs = rsqrtf(ss * (1.0f / 1024.0f) + 1e-6f);
#pragma unroll
            for (int i = 0; i < 4; ++i) {
                h4 o; o[0] = (hf)(v[i][0] * rs * gv[i][0]); o[1] = (hf)(v[i][1] * rs * gv[i][1]); o[2] = (hf)(v[i][2] * rs * gv[i][2]); o[3] = (hf)(v[i][3] * rs * gv[i][3]);
                *(h4*)(hn0 + (size_t)row * DM + i * 256 + lane * 4) = o;
            }
        }
    }
    {
        const int gt = blockIdx.x * NTHR + tid;
        if (gt < 2048) {
            const int g = gt >> 6, p = gt & 63;
            const double dt = exp((double)P.in[8][g]);
            const double ar = (double)P.in[9][gt], ai = (double)P.in[10][gt];
            const double mag = exp(ar * dt), ang = ai * dt;
            const double abr = mag * cos(ang), abi = mag * sin(ang);
            const double den = ar * ar + ai * ai;
            const double em1 = expm1(ar * dt);
            const double s2 = sin(0.5 * ang);
            const double nr = em1 * cos(ang) - 2.0 * s2 * s2, ni = abi;
            const double fr = (nr * ar + ni * ai) / den, fi = (ni * ar - nr * ai) / den;
            float* tab_ab = (float*)(ws + WS_TAB + TAB_AB); float* tab_at = (float*)(ws + WS_TAB + TAB_AT);
            tab_ab[gt * 2] = (float)abr; tab_ab[gt * 2 + 1] = (float)abi;
            double pr = abr, pi = abi;
#pragma unroll
            for (int i = 0; i < 6; ++i) { const double nr2 = pr * pr - pi * pi, ni2 = 2.0 * pr * pi; pr = nr2; pi = ni2; }
            tab_at[gt * 2] = (float)pr; tab_at[gt * 2 + 1] = (float)pi;
            if (p == 0) ((float*)(ws + WS_TAB + TAB_DT))[g] = (float)dt;
            hf* bbs = (hf*)(ws + WS_TAB + TAB_BBS); hf* cri = (hf*)(ws + WS_TAB + TAB_CRI);
            const double inv_dt = 1.0 / dt;
            for (int h = 0; h < 16; ++h) {
                const double br = (double)P.in[11][(size_t)gt * 16 + h], bi = (double)P.in[12][(size_t)gt * 16 + h];
                bbs[((size_t)g * 128 + p) * 16 + h]      = (hf)(float)((fr * br - fi * bi) * inv_dt);
                bbs[((size_t)g * 128 + 64 + p) * 16 + h] = (hf)(float)((fr * bi + fi * br) * inv_dt);
                cri[((size_t)g * 16 + h) * 128 + 2 * p]     = (hf)P.in[13][((size_t)g * 16 + h) * 64 + p];
                cri[((size_t)g * 16 + h) * 128 + 2 * p + 1] = (hf)(-P.in[14][((size_t)g * 16 + h) * 64 + p]);
            }
        }
    }
    {
        const int gt = blockIdx.x * NTHR + tid;
        if (gt < 8192) {
            const int d = gt;
            int bk;
            if (d < 16) bk = d;
            else {
                const int thr[15] = {21, 27, 35, 46, 59, 77, 99, 128, 166, 216, 280, 363, 470, 609, 790};
                bk = 16;
#pragma unroll
                for (int i = 0; i < 15; ++i) bk += (d >= thr[i]) ? 1 : 0;
            }
            ((unsigned char*)(ws + WS_TAB + TAB_BKT))[d] = (unsigned char)bk;
            if (d < 128) {
                float* b0 = (float*)(ws + WS_TAB + TAB_BIAS0);
#pragma unroll
                for (int h = 0; h < 8; ++h) b0[h * 128 + d] = P.in[1][bk * 8 + h];
            }
        }
    }
}

namespace pg8 {
constexpr int BM = 256, BK = 64, HALF = 128, HTB = HALF * BK * 2, STAGE_BYTES = 8 * HTB, NXCD = 8, WGM = 8;
__device__ __forceinline__ int lds_byte(int r, int c) { const int st = (r >> 4) * 2 + (c >> 5), rr = r & 15, cc = c & 31, ob = rr * 64 + cc * 2; return st * 1024 + (ob ^ (((ob >> 9) & 1) << 5)); }
__device__ __forceinline__ void stage_rc(int b, int& R, int& C) { const int st = b / 1024, sb = b % 1024, swz = sb ^ (((sb >> 9) & 1) << 5); R = (st >> 1) * 16 + swz / 64; C = (st & 1) * 32 + (swz % 64) / 2; }
__device__ __forceinline__ int perm32(int rho) { const int n = rho >> 4, i = rho & 15; return 8 * (i >> 2) + 4 * n + (i & 3); }
struct Unit { int pm, pn; };
struct StaticOrder {
    int nM, nN, nwg, G, c;
    __device__ void init(int M, int N, int G_, int c_) { nM = M / BM; nN = N / BM; nwg = nM * nN; G = G_; c = c_; }
    __device__ bool next(int i, Unit& u) const {
        const long L = (long)i * G + c; if (L >= nwg) return false;
        int wgid = (int)L; { const int q = nwg / NXCD, r = nwg % NXCD, xcd = wgid % NXCD, off = wgid / NXCD; wgid = (xcd < r ? xcd * (q + 1) : r * (q + 1) + (xcd - r) * q) + off; }
        const int nig = WGM * nN, gid = wgid / nig, fm = gid * WGM, gsz = (nM - fm) < WGM ? (nM - fm) : WGM;
        u.pm = fm + ((wgid % nig) % gsz); u.pn = (wgid % nig) / gsz; return true;
    }
};

template <class Epi>
__device__ __forceinline__ void gemm_phase(LAS unsigned char* lds, const hf* gA, const hf* gBt, int N, int K, const Epi& E) {
    const int tid = threadIdx.x, wid = __builtin_amdgcn_readfirstlane(tid >> 6), lane = tid & 63, wr = wid >> 2, wc = wid & 3, fr = lane & 15, fq = lane >> 4;
    const int nt = K / BK;
    StaticOrder S; S.init(MTOK, N, (int)gridDim.x, (int)blockIdx.x);
    unsigned voffA[2], voffB[2];
#pragma unroll
    for (int i = 0; i < 2; ++i) { int R, C; stage_rc(tid * 16 + i * 8192, R, C); const int Rb = Epi::PERM ? ((R & ~31) + perm32(R & 31)) : R;
        voffA[i] = (unsigned)(R * K + C) * 2u; voffB[i] = (unsigned)(Rb * K + C) * 2u; }
    const size_t kstep = (size_t)(BK * 2);
    const size_t hstep = (size_t)HALF * K * 2;
    const size_t tstep = 2 * hstep;
    const unsigned ldsw = (unsigned)wid * 1024u;
    const int aoff = lds_byte(wr * 64 + fr, fq * 8), boff = lds_byte(wc * 32 + fr, fq * 8);
#define PG8_SA(b, h) (((b) * 2 + (h)) * HTB)
#define PG8_SB(b, h) ((4 + (b) * 2 + (h)) * HTB)
#define PG8_STAGE(bufoff, gbase, voff) do { _Pragma("unroll") for (int _i = 0; _i < 2; ++_i) \
        __builtin_amdgcn_global_load_lds((const unsigned*)((const char*)(gbase) + (voff)[_i]), (LAS unsigned*)(lds + (bufoff) + ldsw + _i * 8192), 16, 0, 0); } while (0)
#define PG8_LDA(dst, b, h) do { _Pragma("unroll") for (int m = 0; m < 4; ++m) _Pragma("unroll") for (int k = 0; k < 2; ++k) dst[m][k] = *(const LAS h8*)(lds + PG8_SA(b, h) + aoff + m * 2048 + k * 1024); } while (0)
#define PG8_LDB(dst, b, h) do { _Pragma("unroll") for (int n = 0; n < 2; ++n) _Pragma("unroll") for (int k = 0; k < 2; ++k) dst[n][k] = *(const LAS h8*)(lds + PG8_SB(b, h) + boff + n * 2048 + k * 1024); } while (0)
#define PG8_MMA(ai, bj, At, Bt) do { __builtin_amdgcn_s_setprio(1); _Pragma("unroll") for (int m = 0; m < 4; ++m) _Pragma("unroll") for (int n = 0; n < 2; ++n) _Pragma("unroll") for (int k = 0; k < 2; ++k) \
        acc[ai][bj][m][n] = __builtin_amdgcn_mfma_f32_16x16x32_f16(Bt[n][k], At[m][k], acc[ai][bj][m][n], 0, 0, 0); __builtin_amdgcn_s_setprio(0); } while (0)
#define PG8_WAIT_V(n) asm volatile("s_waitcnt vmcnt(" #n ")" ::: "memory")
#define PG8_WAIT_L(n) asm volatile("s_waitcnt lgkmcnt(" #n ")" ::: "memory")
#define PG8_BAR __builtin_amdgcn_s_barrier()
#define PG8_SCHED __builtin_amdgcn_sched_barrier(0)
    Unit cur, nxt; int ui = 0;
    if (!S.next(0, cur)) return;
    f4 acc[2][2][4][2];
#pragma unroll
    for (int a = 0; a < 2; ++a)
#pragma unroll
        for (int b = 0; b < 2; ++b)
#pragma unroll
            for (int m = 0; m < 4; ++m)
#pragma unroll
                for (int n = 0; n < 2; ++n) acc[a][b][m][n] = (f4){0.f, 0.f, 0.f, 0.f};
    h8 At[4][2], B0[2][2], B1[2][2];
    const char* cA = (const char*)gA + (size_t)cur.pm * tstep; const char* cB = (const char*)gBt + (size_t)cur.pn * tstep;
    PG8_STAGE(PG8_SB(0, 0), cB, voffB); PG8_STAGE(PG8_SB(0, 1), cB + hstep, voffB); PG8_STAGE(PG8_SA(0, 0), cA, voffA); PG8_STAGE(PG8_SA(0, 1), cA + hstep, voffA);
    if (wr == 1) PG8_BAR;
    PG8_WAIT_V(2); PG8_BAR;
    PG8_STAGE(PG8_SB(1, 0), cB + kstep, voffB); PG8_STAGE(PG8_SA(1, 0), cA + kstep, voffA); PG8_STAGE(PG8_SB(1, 1), cB + hstep + kstep, voffB);
    PG8_WAIT_V(6); PG8_BAR;
    for (;;) {
        const bool has_next = S.next(ui + 1, nxt);
        const char* nA = has_next ? (const char*)gA + (size_t)nxt.pm * tstep : cA; const char* nB = has_next ? (const char*)gBt + (size_t)nxt.pn * tstep : cB;
        for (int t = 0; t < nt; t += 2) {
            const bool last = (t == nt - 2);
            const char* a1 = cA + (size_t)(t + 1) * kstep;
            const char* a2 = last ? nA : cA + (size_t)(t + 2) * kstep; const char* b2 = last ? nB : cB + (size_t)(t + 2) * kstep;
            const char* a3 = a2 + kstep; const char* b3 = b2 + kstep;
            PG8_LDB(B0, 0, 0); PG8_LDB(B1, 0, 1); PG8_SCHED; PG8_LDA(At, 0, 0); PG8_STAGE(PG8_SA(1, 1), a1 + hstep, voffA);
            PG8_WAIT_V(8); PG8_WAIT_L(0); PG8_BAR; PG8_MMA(0, 0, At, B0); PG8_MMA(0, 1, At, B1); PG8_BAR; PG8_SCHED;
            PG8_LDA(At, 0, 1); PG8_STAGE(PG8_SB(0, 0), b2, voffB); PG8_STAGE(PG8_SB(0, 1), b2 + hstep, voffB); PG8_STAGE(PG8_SA(0, 0), a2, voffA);
            PG8_WAIT_V(8); PG8_WAIT_L(0); PG8_BAR; PG8_MMA(1, 0, At, B0); PG8_MMA(1, 1, At, B1); PG8_BAR; PG8_SCHED;
            PG8_LDB(B0, 1, 0); PG8_LDB(B1, 1, 1); PG8_SCHED; PG8_LDA(At, 1, 0); PG8_STAGE(PG8_SA(0, 1), a2 + hstep, voffA);
            PG8_WAIT_V(8); PG8_WAIT_L(0); PG8_BAR; PG8_MMA(0, 0, At, B0); PG8_MMA(0, 1, At, B1); PG8_BAR; PG8_SCHED;
            PG8_LDA(At, 1, 1); PG8_STAGE(PG8_SB(1, 0), b3, voffB); PG8_STAGE(PG8_SB(1, 1), b3 + hstep, voffB); PG8_STAGE(PG8_SA(1, 0), a3, voffA);
            PG8_WAIT_V(8); PG8_WAIT_L(0); PG8_BAR; PG8_MMA(1, 0, At, B0); PG8_MMA(1, 1, At, B1); PG8_BAR; PG8_SCHED;
        }
        if (wr == 0) PG8_BAR;
        E(acc, cur, wr, wc, fr, fq, lds);
        if (!has_next) break;
#pragma unroll
        for (int a = 0; a < 2; ++a)
#pragma unroll
            for (int b = 0; b < 2; ++b)
#pragma unroll
                for (int m = 0; m < 4; ++m)
#pragma unroll
                    for (int n = 0; n < 2; ++n) acc[a][b][m][n] = (f4){0.f, 0.f, 0.f, 0.f};
        cur = nxt; cA = nA; cB = nB; ++ui;
        if (wr == 1) PG8_BAR;
    }
    PG8_WAIT_V(0);
    PG8_BAR;
#undef PG8_SA
#undef PG8_SB
#undef PG8_STAGE
#undef PG8_LDA
#undef PG8_LDB
#undef PG8_MMA
#undef PG8_WAIT_V
#undef PG8_WAIT_L
#undef PG8_BAR
#undef PG8_SCHED
}
}

constexpr int EPI_LDS = 131072;
#define EPI_BAR() do { asm volatile("s_waitcnt lgkmcnt(0)" ::: "memory"); __builtin_amdgcn_s_barrier(); asm volatile("" ::: "memory"); } while (0)
typedef f4 acc_t[2][2][4][2];
__device__ __forceinline__ h8 pack8(const f4& a, const f4& b) { h8 o; o[0] = (hf)a[0]; o[1] = (hf)a[1]; o[2] = (hf)a[2]; o[3] = (hf)a[3]; o[4] = (hf)b[0]; o[5] = (hf)b[1]; o[6] = (hf)b[2]; o[7] = (hf)b[3]; return o; }
__device__ __forceinline__ unsigned long long pack8_fp8(const f4& a, const f4& b) {
    int lo = __builtin_amdgcn_cvt_pk_fp8_f32(a[0], a[1], 0, false); lo = __builtin_amdgcn_cvt_pk_fp8_f32(a[2], a[3], lo, true);
    int hi = __builtin_amdgcn_cvt_pk_fp8_f32(b[0], b[1], 0, false); hi = __builtin_amdgcn_cvt_pk_fp8_f32(b[2], b[3], hi, true);
    return ((unsigned long long)(unsigned)hi << 32) | (unsigned)lo;
}
__device__ __forceinline__ float ss32(const f4& a, const f4& b) {
    float s = a[0] * a[0] + a[1] * a[1] + a[2] * a[2] + a[3] * a[3] + b[0] * b[0] + b[1] * b[1] + b[2] * b[2] + b[3] * b[3];
    s += __shfl_xor(s, 16); s += __shfl_xor(s, 32); return s;
}

struct EpiIn0 {
    static constexpr bool PERM = true;
    const Params* P;
    __device__ __forceinline__ void operator()(acc_t& acc, const pg8::Unit& u, int wr, int wc, int fr, int fq, LAS unsigned char* lds) const {
        hf* z0 = (hf*)(P->ws + WS_RB);
        LAS float* xch = (LAS float*)(lds + EPI_LDS);
        const bool anynorm = (u.pn <= 1);
        if (anynorm) {
#pragma unroll
            for (int bj = 0; bj < 2; ++bj)
#pragma unroll
                for (int ai = 0; ai < 2; ++ai)
#pragma unroll
                    for (int m = 0; m < 4; ++m) {
                        const float s = ss32(acc[ai][bj][m][0], acc[ai][bj][m][1]);
                        if (fq == 0) xch[((wr * 4 + wc) * 2 + bj) * 128 + ai * 64 + m * 16 + fr] = s;
                    }
            EPI_BAR();
        }
#pragma unroll
        for (int bj = 0; bj < 2; ++bj) {
            const int cg = u.pn * 256 + bj * 128;
            const int cb = (cg < 512) ? cg : cg + 256;
            const int col0 = cb + wc * 32 + fq * 8;
            const bool norm = (cb < 512), act = (cb >= 768 && cb < 1280) || (cb >= 1792);
            f4 g0 = (f4){1.f, 1.f, 1.f, 1.f}, g1 = g0;
            if (norm) { const float* gw = P->in[5]; g0 = *(const f4*)(gw + (col0 & 63)); g1 = *(const f4*)(gw + (col0 & 63) + 4); }
#pragma unroll
            for (int ai = 0; ai < 2; ++ai)
#pragma unroll
                for (int m = 0; m < 4; ++m) {
                    const size_t row = (size_t)u.pm * 256 + ai * 128 + wr * 64 + m * 16 + fr;
                    f4 a = acc[ai][bj][m][0], b = acc[ai][bj][m][1];
                    if (norm) {
                        const int ri = ai * 64 + m * 16 + fr;
                        const float tot = xch[((wr * 4 + wc) * 2 + bj) * 128 + ri] + xch[((wr * 4 + (wc ^ 1)) * 2 + bj) * 128 + ri];
                        const float sc = rsqrtf(tot * (1.0f / 64.0f) + 1e-6f);
                        a = a * sc * g0; b = b * sc * g1;
                    } else if (act) {
#pragma unroll
                        for (int e = 0; e < 4; ++e) { a[e] = silu_f(a[e]); b[e] = silu_f(b[e]); }
                    }
                    *(h8*)(z0 + row * N0 + col0) = pack8(a, b);
                }
        }
        if (anynorm) EPI_BAR();
    }
};

struct EpiGlu {
    static constexpr bool PERM = true;
    const Params* P;
    __device__ __forceinline__ void operator()(acc_t& acc, const pg8::Unit& u, int wr, int wc, int fr, int fq, LAS unsigned char* lds) const {
        const hf* z0 = (const hf*)(P->ws + WS_RB); hf* cat = (hf*)(P->ws + WS_RA);
        const float* gb = P->in[17];
        h4 sg[2][2][4];
        f4 ba[2], bb[2];
#pragma unroll
        for (int bj = 0; bj < 2; ++bj) {
            const int j0 = ((u.pn * 256 + bj * 128 + wc * 32 + fq * 8) >> 3) * 4;
            ba[bj] = *(const f4*)(gb + j0); bb[bj] = *(const f4*)(gb + 512 + j0);
#pragma unroll
            for (int ai = 0; ai < 2; ++ai)
#pragma unroll
                for (int m = 0; m < 4; ++m) {
                    const size_t row = (size_t)u.pm * 256 + ai * 128 + wr * 64 + m * 16 + fr;
                    sg[bj][ai][m] = *(const h4*)(z0 + row * N0 + 1792 + j0);
                }
        }
#pragma unroll
        for (int bj = 0; bj < 2; ++bj) {
            const int j0 = ((u.pn * 256 + bj * 128 + wc * 32 + fq * 8) >> 3) * 4;
#pragma unroll
            for (int ai = 0; ai < 2; ++ai)
#pragma unroll
                for (int m = 0; m < 4; ++m) {
                    const size_t row = (size_t)u.pm * 256 + ai * 128 + wr * 64 + m * 16 + fr;
                    const f4 a = acc[ai][bj][m][0] + ba[bj], g = acc[ai][bj][m][1] + bb[bj];
                    h4 o;
#pragma unroll
                    for (int e = 0; e < 4; ++e) o[e] = (hf)(a[e] * sigmoid_f(g[e]) * (float)sg[bj][ai][m][e]);
                    *(h4*)(cat + row * DM + 512 + j0) = o;
                }
        }
    }
};

struct EpiOut0 {
    static constexpr bool PERM = false;
    const Params* P;
    __device__ __forceinline__ void operator()(acc_t& acc, const pg8::Unit& u, int wr, int wc, int fr, int fq, LAS unsigned char* lds) const {
        const float* x = P->in[0];
        hf* h1 = (hf*)(P->ws + WS_H1); float* rowss = (float*)(P->ws + WS_ROWSS);
        const size_t row0 = (size_t)u.pm * 256 + wr * 64 + fr;
        const int colb = u.pn * 256 + wc * 32 + fq * 4;
        f4 xv[2][8];
#define EO0_LOAD(bt, dst) do { _Pragma("unroll") for (int m2 = 0; m2 < 2; ++m2) _Pragma("unroll") for (int bj = 0; bj < 2; ++bj) _Pragma("unroll") for (int n = 0; n < 2; ++n) \
            dst[(m2 * 2 + bj) * 2 + n] = *(const f4*)(x + (row0 + ((bt) >> 1) * 128 + (((bt) & 1) * 2 + m2) * 16) * DM + colb + bj * 128 + n * 16); } while (0)
        EO0_LOAD(0, xv[0]);
#pragma unroll
        for (int bt = 0; bt < 4; ++bt) {
            if (bt + 1 < 4) EO0_LOAD(bt + 1, xv[(bt + 1) & 1]);
            const int ai = bt >> 1;
#pragma unroll
            for (int m2 = 0; m2 < 2; ++m2) {
                const int m = (bt & 1) * 2 + m2;
                const size_t row = row0 + ai * 128 + m * 16;
                float ss = 0.f;
#pragma unroll
                for (int bj = 0; bj < 2; ++bj)
#pragma unroll
                    for (int n = 0; n < 2; ++n) {
                        const int col = colb + bj * 128 + n * 16;
                        const f4 h = xv[bt & 1][(m2 * 2 + bj) * 2 + n] + acc[ai][bj][m][n];
                        h4 o; o[0] = (hf)h[0]; o[1] = (hf)h[1]; o[2] = (hf)h[2]; o[3] = (hf)h[3];
                        *(h4*)(h1 + row * DM + col) = o;
                        const float q0 = (float)o[0], q1 = (float)o[1], q2 = (float)o[2], q3 = (float)o[3];
                        ss += q0 * q0 + q1 * q1 + q2 * q2 + q3 * q3;
                    }
                ss += __shfl_xor(ss, 16); ss += __shfl_xor(ss, 32);
                if (fq == 0) rowss[row * 16 + u.pn * 4 + wc] = ss;
            }
        }
#undef EO0_LOAD
    }
};

struct EpiIn1 {
    static constexpr bool PERM = true;
    const Params* P;
    __device__ __forceinline__ void operator()(acc_t& acc, const pg8::Unit& u, int wr, int wc, int fr, int fq, LAS unsigned char* lds) const {
        unsigned char* ws = P->ws;
        LAS float* xch = (LAS float*)(lds + EPI_LDS);
        LAS float* rsx = (LAS float*)(lds + EPI_LDS + 8192);
        if (threadIdx.x < 256) {
            const float* rowss = (const float*)(ws + WS_ROWSS) + ((size_t)u.pm * 256 + threadIdx.x) * 16;
            float s = 0.f;
#pragma unroll
            for (int i = 0; i < 16; ++i) s += rowss[i];
            rsx[threadIdx.x] = rsqrtf(s * (1.0f / 1024.0f) + 1e-6f);
        }
        EPI_BAR();
#pragma unroll
        for (int ai = 0; ai < 2; ++ai)
#pragma unroll
            for (int m = 0; m < 4; ++m) {
                const float rs = rsx[ai * 128 + wr * 64 + m * 16 + fr];
#pragma unroll
                for (int bj = 0; bj < 2; ++bj) { acc[ai][bj][m][0] *= rs; acc[ai][bj][m][1] *= rs; }
            }
        const bool anynorm = (u.pn <= 4);
        if (anynorm) {
#pragma unroll
            for (int bj = 0; bj < 2; ++bj)
#pragma unroll
                for (int ai = 0; ai < 2; ++ai)
#pragma unroll
                    for (int m = 0; m < 4; ++m) {
                        const float s = ss32(acc[ai][bj][m][0], acc[ai][bj][m][1]);
                        if (fq == 0) xch[((wr * 4 + wc) * 2 + bj) * 128 + ai * 64 + m * 16 + fr] = s;
                    }
            EPI_BAR();
        }
#pragma unroll
        for (int bj = 0; bj < 2; ++bj) {
            const int cb = u.pn * 256 + bj * 128;
            const int cl = wc * 32 + fq * 8;
            const int col0 = cb + cl;
#pragma unroll
            for (int ai = 0; ai < 2; ++ai)
#pragma unroll
                for (int m = 0; m < 4; ++m) {
                    const size_t row = (size_t)u.pm * 256 + ai * 128 + wr * 64 + m * 16 + fr;
                    f4 a = acc[ai][bj][m][0], b = acc[ai][bj][m][1];
                    if (cb < 1280) {
                        const int ri = ai * 64 + m * 16 + fr;
                        float tot = 0.f;
#pragma unroll
                        for (int c2 = 0; c2 < 4; ++c2) tot += xch[((wr * 4 + c2) * 2 + bj) * 128 + ri];
                        const float sc = rsqrtf(tot * (1.0f / 128.0f) + 1e-6f);
                        const float* gw = (cb < 1024) ? P->in[20] : P->in[21];
                        const f4 g0 = *(const f4*)(gw + cl), g1 = *(const f4*)(gw + cl + 4);
                        a = a * sc * g0; b = b * sc * g1;
                        const size_t kvrow = ((size_t)((row >> 13) * 2 + ((cb >> 7) & 1)) * SEQ + (row & 8191)) * 256;
                        unsigned char* dst = (cb < 1024) ? (ws + WS_RA + row * 1024 + col0) : (ws + WS_V1 + kvrow + cl);
                        *(unsigned long long*)dst = pack8_fp8(a, b);
                    } else if (cb < 1536) {
                        const size_t kvrow = ((size_t)((row >> 13) * 2 + ((cb >> 7) & 1)) * SEQ + (row & 8191)) * 256;
                        *(unsigned long long*)(ws + WS_V1 + kvrow + 128 + cl) = pack8_fp8(a, b);
                    } else if (cb < 2560) {
#pragma unroll
                        for (int e = 0; e < 4; ++e) { a[e] = silu_f(a[e]); b[e] = silu_f(b[e]); }
                        *(h8*)((hf*)(ws + WS_RB + 32 * MiB) + row * 1024 + (col0 - 1536)) = pack8(a, b);
                    } else if (cb < 3072) {
                        *(h8*)((hf*)(ws + WS_RC) + row * 512 + (col0 - 2560)) = pack8(a, b);
                    } else if (cb == 3072) {
                        if (cl < 64) *(h8*)((hf*)(ws + WS_KI) + row * 64 + cl) = pack8(a, b);
                        else if (cl == 64) { float* wi = (float*)(ws + WS_WI) + row * 8; *(f4*)wi = a * 0.04419417382415922f; *(f4*)(wi + 4) = b * 0.04419417382415922f; }
                    }
                }
        }
        EPI_BAR();
    }
};

struct EpiOut1 {
    static constexpr bool PERM = false;
    const Params* P;
    __device__ __forceinline__ void operator()(acc_t& acc, const pg8::Unit& u, int wr, int wc, int fr, int fq, LAS unsigned char* lds) const {
        float* out = P->out; const hf* h1 = (const hf*)(P->ws + WS_H1);
        const size_t row0 = (size_t)u.pm * 256 + wr * 64 + fr;
        const int colb = u.pn * 256 + wc * 32 + fq * 4;
        h4 hv[2][4][2][2];
#pragma unroll
        for (int ai = 0; ai < 2; ++ai)
#pragma unroll
            for (int m = 0; m < 4; ++m)
#pragma unroll
                for (int bj = 0; bj < 2; ++bj)
#pragma unroll
                    for (int n = 0; n < 2; ++n) hv[ai][m][bj][n] = *(const h4*)(h1 + (row0 + ai * 128 + m * 16) * DM + colb + bj * 128 + n * 16);
#pragma unroll
        for (int ai = 0; ai < 2; ++ai)
#pragma unroll
            for (int m = 0; m < 4; ++m)
#pragma unroll
                for (int bj = 0; bj < 2; ++bj)
#pragma unroll
                    for (int n = 0; n < 2; ++n) {
                        f4 o = acc[ai][bj][m][n];
                        const h4 v = hv[ai][m][bj][n];
                        o[0] += (float)v[0]; o[1] += (float)v[1]; o[2] += (float)v[2]; o[3] += (float)v[3];
                        *(f4*)(out + (row0 + ai * 128 + m * 16) * DM + colb + bj * 128 + n * 16) = o;
                    }
    }
};

__device__ __forceinline__ l2 lane_tr(const l2& v, int bpa) {
    typedef int i4v __attribute__((ext_vector_type(4)));
    i4v x = __builtin_bit_cast(i4v, v);
#pragma unroll
    for (int e = 0; e < 4; ++e) x[e] = __builtin_amdgcn_ds_bpermute(bpa, x[e]);
    return __builtin_bit_cast(l2, x);
}
__device__ __forceinline__ h8 lane_tr(const h8& v, int bpa) { return __builtin_bit_cast(h8, lane_tr(__builtin_bit_cast(l2, v), bpa)); }
constexpr int THIN_LD = 2064;
__device__ __forceinline__ void thin_load_a(const hf* A, int r0, char* smem) {
    for (int i = threadIdx.x; i < 8192; i += NTHR) { const int row = i >> 7, pc = i & 127; *(h8*)(smem + row * THIN_LD + pc * 16) = *(const h8*)(A + (size_t)(r0 + row) * 1024 + pc * 8); }
}
template <int NT>
__device__ __forceinline__ void thin_mma(const char* smem, const hf* Wt, int n0, f4 (&acc)[4][NT], int lane) {
    const int l15 = lane & 15, g4 = lane >> 4, bpa = 4 * (4 * l15 + g4);
    const hf* bp[NT];
#pragma unroll
    for (int t = 0; t < NT; ++t) bp[t] = Wt + (size_t)(n0 + t * 16 + (lane >> 2)) * 1024 + (lane & 3) * 8;
#pragma unroll
    for (int m = 0; m < 4; ++m)
#pragma unroll
        for (int t = 0; t < NT; ++t) acc[m][t] = (f4){0.f, 0.f, 0.f, 0.f};
    h8 bq[2][NT];
#pragma unroll
    for (int t = 0; t < NT; ++t) bq[0][t] = *(const h8*)bp[t];
    const char* ap = smem + l15 * THIN_LD + g4 * 16;
    for (int ks = 0; ks < 32; ks += 2) {
#pragma unroll
        for (int u = 0; u < 2; ++u) {
            const int k1 = ks + u + 1;
            if (k1 < 32) {
#pragma unroll
                for (int t = 0; t < NT; ++t) bq[(u + 1) & 1][t] = *(const h8*)(bp[t] + k1 * 32);
            }
            h8 bf[NT];
#pragma unroll
            for (int t = 0; t < NT; ++t) bf[t] = lane_tr(bq[u][t], bpa);
#pragma unroll
            for (int m = 0; m < 4; ++m) {
                const h8 af = *(const h8*)(ap + m * 16 * THIN_LD + (ks + u) * 64);
#pragma unroll
                for (int t = 0; t < NT; ++t) acc[m][t] = __builtin_amdgcn_mfma_f32_16x16x32_f16(af, bf[t], acc[m][t], 0, 0, 0);
            }
        }
    }
}
__device__ __forceinline__ void thin_kv(const Params& P, char* smem) {
    const int tid = threadIdx.x, lane = tid & 63, w = tid >> 6, l15 = lane & 15, g4 = lane >> 4;
    unsigned char* ws = P.ws;
    hf* z0 = (hf*)(ws + WS_RB);
    float* xch = (float*)(smem + 64 * THIN_LD);
    for (int panel = blockIdx.x; panel < 256; panel += gridDim.x) {
        thin_load_a((const hf*)(ws + WS_RA), panel * 64, smem);
        __syncthreads();
        f4 acc[4][2];
        thin_mma<2>(smem, (const hf*)(ws + WS_WT_IN0), 2048 + w * 32, acc, lane);
        float ssl[4][4];
        if (w < 4) {
#pragma unroll
            for (int m = 0; m < 4; ++m)
#pragma unroll
                for (int r = 0; r < 4; ++r) {
                    float ss = acc[m][0][r] * acc[m][0][r] + acc[m][1][r] * acc[m][1][r];
                    ss = red16(ss); ssl[m][r] = ss;
                    if (l15 == 0) xch[w * 64 + m * 16 + 4 * g4 + r] = ss;
                }
        }
        __syncthreads();
        float gk[2] = {1.f, 1.f};
        if (w < 4) { gk[0] = P.in[6][(w & 1) * 32 + l15]; gk[1] = P.in[6][(w & 1) * 32 + 16 + l15]; }
#pragma unroll
        for (int m = 0; m < 4; ++m)
#pragma unroll
            for (int r = 0; r < 4; ++r) {
                float sc = 1.f;
                if (w < 4) sc = rsqrtf((ssl[m][r] + xch[(w ^ 1) * 64 + m * 16 + 4 * g4 + r]) * (1.0f / 64.0f) + 1e-6f);
                const size_t row = (size_t)panel * 64 + m * 16 + 4 * g4 + r;
#pragma unroll
                for (int t = 0; t < 2; ++t) z0[row * N0 + 512 + w * 32 + t * 16 + l15] = (hf)(acc[m][t][r] * sc * gk[t]);
            }
        __syncthreads();
    }
}
__device__ __forceinline__ void thin_ki(const Params& P, char* smem) {
    const int tid = threadIdx.x, lane = tid & 63, w = tid >> 6, l15 = lane & 15, g4 = lane >> 4;
    unsigned char* ws = P.ws;
    float* rsx = (float*)(smem + 64 * THIN_LD);
    for (int panel = blockIdx.x; panel < 256; panel += gridDim.x) {
        thin_load_a((const hf*)(ws + WS_H1), panel * 64, smem);
        if (tid < 64) {
            const float* rowss = (const float*)(ws + WS_ROWSS) + ((size_t)panel * 64 + tid) * 16;
            float s = 0.f;
#pragma unroll
            for (int i = 0; i < 16; ++i) s += rowss[i];
            rsx[tid] = rsqrtf(s * (1.0f / 1024.0f) + 1e-6f);
        }
        __syncthreads();
        if (w < 5) {
            f4 acc[4][1];
            thin_mma<1>(smem, (const hf*)(ws + WS_WT_IN1), 3072 + w * 16, acc, lane);
#pragma unroll
            for (int m = 0; m < 4; ++m)
#pragma unroll
                for (int r = 0; r < 4; ++r) {
                    const int rl = m * 16 + 4 * g4 + r;
                    const size_t row = (size_t)panel * 64 + rl;
                    const float v = acc[m][0][r] * rsx[rl];
                    if (w < 4) ((hf*)(ws + WS_KI))[row * 64 + w * 16 + l15] = (hf)v;
                    else if (l15 < 8) ((float*)(ws + WS_WI))[row * 8 + l15] = v * 0.04419417382415922f;
                }
        }
        __syncthreads();
    }
}

__device__ __forceinline__ void swa_item(const Params& P, int item, char* smem) {
    const int tid = threadIdx.x, lane = tid & 63, w = tid >> 6, l15 = lane & 15, g4 = lane >> 4;
    unsigned char* ws = P.ws;
    const int kv = item & 1, n = (item >> 1) & 63, b = item >> 7;
    const hf* z0 = (const hf*)(ws + WS_RB);
    hf* cat = (hf*)(ws + WS_RA);
    hf* sK = (hf*)smem;
    hf* sV = (hf*)(smem + 32768);
    float* sBias = (float*)(smem + 32768 + 36864);
    constexpr int VST = 72;
    const int tok0 = b * SEQ + n * 128;
    for (int i = tid; i < 256 * 8; i += NTHR) {
        const int j = i >> 3, ch = i & 7;
        h8 v = (h8){0, 0, 0, 0, 0, 0, 0, 0};
        if (n > 0 || j >= 128) v = *(const h8*)(z0 + (size_t)(tok0 - 128 + j) * N0 + 512 + kv * 64 + ch * 8);
        *(h8*)(sK + j * 64 + ((ch ^ (j & 7)) * 8)) = v;
    }
    for (int i = tid; i < 256 * 8; i += NTHR) {
        const int j = i >> 3, ch = i & 7;
        h8 v = (h8){0, 0, 0, 0, 0, 0, 0, 0};
        if (n > 0 || j >= 128) v = *(const h8*)(z0 + (size_t)(tok0 - 128 + j) * N0 + 640 + kv * 64 + ch * 8);
        *(h8*)(sV + j * VST + ch * 8) = v;
    }
    {
        const float* b0 = (const float*)(ws + WS_TAB + TAB_BIAS0);
        sBias[tid] = b0[(kv * 4 + (tid >> 7)) * 128 + (tid & 127)];
    }
    __syncthreads();
    const int g = w >> 1, th = w & 1, h = kv * 4 + g;
    const float sink = P.in[7][h];
    for (int tt = 0; tt < 4; ++tt) {
        const int i0 = th * 64 + tt * 16;
        const int tokrow = tok0 + i0 + l15;
        h8 qf[2];
#pragma unroll
        for (int ks = 0; ks < 2; ++ks) qf[ks] = *(const h8*)(z0 + (size_t)tokrow * N0 + h * 64 + ks * 32 + g4 * 8);
        f4 s[9];
        const int jt0 = i0 >> 4;
#pragma unroll
        for (int c = 0; c < 9; ++c) {
            s[c] = (f4){0.f, 0.f, 0.f, 0.f};
            const int key = (jt0 + c) * 16 + l15;
#pragma unroll
            for (int ks = 0; ks < 2; ++ks) {
                const h8 kf = *(const h8*)(sK + key * 64 + (((ks * 4 + g4) ^ (key & 7)) * 8));
                s[c] = __builtin_amdgcn_mfma_f32_16x16x32_f16(kf, qf[ks], s[c], 0, 0, 0);
            }
        }
        const int i = i0 + l15;
        float m = sink;
#pragma unroll
        for (int c = 0; c < 9; ++c)
#pragma unroll
            for (int r = 0; r < 4; ++r) {
                const int j = (jt0 + c) * 16 + 4 * g4 + r;
                const int d = i + 128 - j;
                const bool valid = (d >= 0) && (d < 128) && (n > 0 || j >= 128);
                const float lg = valid ? (s[c][r] * 0.125f + sBias[g * 128 + (d & 127)]) : -1e30f;
                s[c][r] = lg; m = fmaxf(m, lg);
            }
        m = fmaxf(m, __shfl_xor(m, 16)); m = fmaxf(m, __shfl_xor(m, 32));
        float sum = 0.f;
#pragma unroll
        for (int c = 0; c < 9; ++c)
#pragma unroll
            for (int r = 0; r < 4; ++r) { const float p = (s[c][r] > -1e29f) ? __expf(s[c][r] - m) : 0.f; s[c][r] = p; sum += p; }
        sum += __shfl_xor(sum, 16); sum += __shfl_xor(sum, 32);
        sum += __expf(sink - m);
        const float inv = 1.0f / sum;
        f4 o[4];
#pragma unroll
        for (int mt = 0; mt < 4; ++mt) o[mt] = (f4){0.f, 0.f, 0.f, 0.f};
#pragma unroll
        for (int k2 = 0; k2 < 5; ++k2) {
            const int ca = 2 * k2, cb = 2 * k2 + 1;
            h8 pf;
#pragma unroll
            for (int r = 0; r < 4; ++r) { pf[r] = (hf)s[ca][r]; pf[4 + r] = (cb < 9) ? (hf)s[cb][r] : (hf)0; }
            const int q4 = l15 >> 2, p4 = l15 & 3;
#pragma unroll
            for (int mt = 0; mt < 4; ++mt) {
                const fp16x4_t lo = __builtin_amdgcn_ds_read_tr16_b64_v4f16((LAS fp16x4_t*)(sV + ((jt0 + ca) * 16 + 4 * g4 + q4) * VST + mt * 16 + 4 * p4));
                h4 va = __builtin_bit_cast(h4, lo), vb = (h4){0, 0, 0, 0};
                if (cb < 9) { const fp16x4_t hi = __builtin_amdgcn_ds_read_tr16_b64_v4f16((LAS fp16x4_t*)(sV + ((jt0 + cb) * 16 + 4 * g4 + q4) * VST + mt * 16 + 4 * p4)); vb = __builtin_bit_cast(h4, hi); }
                h8 vf; vf[0] = va[0]; vf[1] = va[1]; vf[2] = va[2]; vf[3] = va[3]; vf[4] = vb[0]; vf[5] = vb[1]; vf[6] = vb[2]; vf[7] = vb[3];
                o[mt] = __builtin_amdgcn_mfma_f32_16x16x32_f16(vf, pf, o[mt], 0, 0, 0);
            }
        }
#pragma unroll
        for (int mt = 0; mt < 4; ++mt) {
            const int dcol = h * 64 + mt * 16 + 4 * g4;
            const h4 sg = *(const h4*)(z0 + (size_t)tokrow * N0 + 768 + dcol);
            h4 ov;
#pragma unroll
            for (int r = 0; r < 4; ++r) ov[r] = (hf)(o[mt][r] * inv * (float)sg[r]);
            *(h4*)(cat + (size_t)tokrow * DM + dcol) = ov;
        }
    }
    __syncthreads();
}

template <int MODE>
__device__ __forceinline__ void ssm_item(const Params& P, int item, char* smem) {
    const int tid = threadIdx.x, lane = tid & 63, w = tid >> 6, l15 = lane & 15, g4 = lane >> 4;
    unsigned char* ws = P.ws;
    const int b = item >> 7, c = item & 127;
    const hf* z0 = (const hf*)(ws + WS_RB);
    float* S = (float*)(ws + WS_SC);
    hf* yg = (hf*)(ws + WS_RC);
    float* sBU = (float*)(smem + w * 14592);
    hf* sX = (hf*)(smem + w * 14592 + 10240);
    const float* tab_ab = (const float*)(ws + WS_TAB + TAB_AB);
    const float* tab_at = (const float*)(ws + WS_TAB + TAB_AT);
    const float* tab_dt = (const float*)(ws + WS_TAB + TAB_DT);
    const hf* bbs = (const hf*)(ws + WS_TAB + TAB_BBS);
    const hf* cri = (const hf*)(ws + WS_TAB + TAB_CRI);
    const int tokc = b * SEQ + c * 64;
    float cr[4], ci[4];
#pragma unroll
    for (int q = 0; q < 4; ++q) { cr[q] = 0.f; ci[q] = 0.f; }
    if (MODE == 1) {
        const float* Cb = (const float*)(ws + WS_CIN) + ((size_t)(b * 128 + c) * 32 + w * 4) * 128 + lane;
#pragma unroll
        for (int q = 0; q < 4; ++q) { cr[q] = Cb[q * 128]; ci[q] = Cb[q * 128 + 64]; }
    }
    for (int q = 0; q < 4; ++q) {
        const int g = w * 4 + q;
        const float abr = tab_ab[(g * 64 + lane) * 2], abi = tab_ab[(g * 64 + lane) * 2 + 1];
        h4 bf[8];
#pragma unroll
        for (int nt = 0; nt < 8; ++nt) bf[nt] = *(const h4*)(bbs + ((size_t)g * 128 + nt * 16 + l15) * 16 + 4 * g4);
        h8 cf[4];
        float dtg = 0.f, dsk = 0.f;
        if (MODE == 1) {
#pragma unroll
            for (int ks = 0; ks < 4; ++ks) cf[ks] = *(const h8*)(cri + ((size_t)g * 16 + l15) * 128 + ks * 32 + g4 * 8);
            dtg = tab_dt[g]; dsk = P.in[15][g * 16 + l15];
        }
        float xr = 0.f, xi = 0.f;
        if (MODE == 1) { xr = (q == 0) ? cr[0] : (q == 1) ? cr[1] : (q == 2) ? cr[2] : cr[3]; xi = (q == 0) ? ci[0] : (q == 1) ? ci[1] : (q == 2) ? ci[2] : ci[3]; }
        h4 ufn = *(const h4*)(z0 + (size_t)(tokc + l15) * N0 + 1280 + g * 16 + 4 * g4);
        hf uen[4];
#pragma unroll
        for (int r = 0; r < 4; ++r) uen[r] = (MODE == 1) ? z0[(size_t)(tokc + 4 * g4 + r) * N0 + 1280 + g * 16 + l15] : (hf)0;
#pragma unroll 1
        for (int mt = 0; mt < 4; ++mt) {
            const int tokm = tokc + mt * 16;
            const h4 uf = ufn;
            hf ue[4];
#pragma unroll
            for (int r = 0; r < 4; ++r) ue[r] = uen[r];
            if (mt + 1 < 4) {
                ufn = *(const h4*)(z0 + (size_t)(tokm + 16 + l15) * N0 + 1280 + g * 16 + 4 * g4);
                if (MODE == 1) {
#pragma unroll
                    for (int r = 0; r < 4; ++r) uen[r] = z0[(size_t)(tokm + 16 + 4 * g4 + r) * N0 + 1280 + g * 16 + l15];
                }
            }
#pragma unroll
            for (int nt = 0; nt < 8; ++nt) {
                f4 d = (f4){0.f, 0.f, 0.f, 0.f};
                d = __builtin_amdgcn_mfma_f32_16x16x16f16(uf, bf[nt], d, 0, 0, 0);
                *(f4*)(sBU + (nt * 16 + l15) * 20 + 4 * g4) = d;
            }
            LDS_FENCE();
            f4 bre[4], bim[4];
#pragma unroll
            for (int k = 0; k < 4; ++k) { bre[k] = *(const f4*)(sBU + lane * 20 + 4 * k); bim[k] = *(const f4*)(sBU + (64 + lane) * 20 + 4 * k); }
#pragma unroll
            for (int t = 0; t < 16; ++t) {
                const float bur = bre[t >> 2][t & 3], bui = bim[t >> 2][t & 3];
                const float nr = abr * xr - abi * xi + bur;
                const float ni = abr * xi + abi * xr + bui;
                xr = nr; xi = ni;
                if (MODE == 1) { h2 xv; xv[0] = (hf)xr; xv[1] = (hf)xi; *(h2*)(sX + t * 136 + 2 * lane) = xv; }
            }
            LDS_FENCE();
            if (MODE == 1) {
                f4 y = (f4){0.f, 0.f, 0.f, 0.f};
#pragma unroll
                for (int ks = 0; ks < 4; ++ks) {
                    const h8 xf = *(const h8*)(sX + l15 * 136 + ks * 32 + g4 * 8);
                    y = __builtin_amdgcn_mfma_f32_16x16x32_f16(xf, cf[ks], y, 0, 0, 0);
                }
#pragma unroll
                for (int r = 0; r < 4; ++r) {
                    const size_t row = tokm + 4 * g4 + r;
                    const float u = (float)ue[r];
                    const float yv = dtg * y[r] + dsk * u;
                    yg[row * 512 + g * 16 + l15] = (hf)gelu_tanh_f(yv);
                }
                LDS_FENCE();
            }
        }
        if (MODE == 0) {
            float* Sd = S + ((size_t)(b * 128 + c) * 32 + g) * 128;
            Sd[lane] = xr; Sd[64 + lane] = xi;
        }
    }
}

__device__ __forceinline__ void carry_scan(const Params& P, char* smem) {
    const int tid = threadIdx.x, lane = tid & 63, w = tid >> 6;
    unsigned char* ws = P.ws;
    const float* S = (const float*)(ws + WS_SC);
    float* Cin = (float*)(ws + WS_CIN);
    const float* tab_at = (const float*)(ws + WS_TAB + TAB_AT);
    float* sT = (float*)smem;
    for (int tp = blockIdx.x; tp < 32; tp += gridDim.x) {
        const int task = tp * 2 + (w >> 2), seg = w & 3;
        const int b = task >> 5, g = task & 31;
        const float atr = tab_at[(g * 64 + lane) * 2], ati = tab_at[(g * 64 + lane) * 2 + 1];
        const float* Sp = S + ((size_t)(b * 128 + seg * 32) * 32 + g) * 128 + lane;
        float* Cp = Cin + ((size_t)(b * 128 + seg * 32) * 32 + g) * 128 + lane;
        float sr[32], si[32];
#pragma unroll
        for (int i = 0; i < 32; ++i) { sr[i] = Sp[(size_t)i * 4096]; si[i] = Sp[(size_t)i * 4096 + 64]; }
        float xr = 0.f, xi = 0.f;
#pragma unroll
        for (int i = 0; i < 32; ++i) {
            const float nr = atr * xr - ati * xi + sr[i], ni = atr * xi + ati * xr + si[i];
            sr[i] = xr; si[i] = xi; xr = nr; xi = ni;
        }
        sT[((w >> 2) * 4 + seg) * 128 + lane] = xr; sT[((w >> 2) * 4 + seg) * 128 + 64 + lane] = xi;
        __syncthreads();
        float pr = atr, pi = ati;
#pragma unroll
        for (int i = 0; i < 5; ++i) { const float nr = pr * pr - pi * pi, ni = 2.f * pr * pi; pr = nr; pi = ni; }
        float Xr = 0.f, Xi = 0.f;
        for (int k = 0; k < seg; ++k) {
            const float tr = sT[((w >> 2) * 4 + k) * 128 + lane], ti = sT[((w >> 2) * 4 + k) * 128 + 64 + lane];
            const float nr = pr * Xr - pi * Xi + tr, ni = pr * Xi + pi * Xr + ti;
            Xr = nr; Xi = ni;
        }
        float qr = 1.f, qi = 0.f;
#pragma unroll
        for (int i = 0; i < 32; ++i) {
            Cp[(size_t)i * 4096] = sr[i] + qr * Xr - qi * Xi;
            Cp[(size_t)i * 4096 + 64] = si[i] + qr * Xi + qi * Xr;
            const float nr = qr * atr - qi * ati, ni = qr * ati + qi * atr; qr = nr; qi = ni;
        }
        __syncthreads();
    }
}

constexpr int CAND_CAP = 128;

__device__ __forceinline__ void idx_scores(const h8 (&qf)[8][2], const h8 (&ql)[2], const float (&wv)[8], const h8& k0, const h8& k1, float (&sc)[4]) {
    f4 lin = (f4){0.f, 0.f, 0.f, 0.f};
    lin = __builtin_amdgcn_mfma_f32_16x16x32_f16(k0, ql[0], lin, 0, 0, 0);
    lin = __builtin_amdgcn_mfma_f32_16x16x32_f16(k1, ql[1], lin, 0, 0, 0);
    sc[0] = lin[0]; sc[1] = lin[1]; sc[2] = lin[2]; sc[3] = lin[3];
#pragma unroll
    for (int h = 0; h < 8; ++h) {
        f4 a = (f4){0.f, 0.f, 0.f, 0.f};
        a = __builtin_amdgcn_mfma_f32_16x16x32_f16(k0, qf[h][0], a, 0, 0, 0);
        a = __builtin_amdgcn_mfma_f32_16x16x32_f16(k1, qf[h][1], a, 0, 0, 0);
#pragma unroll
        for (int r = 0; r < 4; ++r) sc[r] = __builtin_fmaf(wv[h], __builtin_fabsf(a[r]), sc[r]);
    }
}
__device__ __forceinline__ float score_t(float s2, float qs) { return __builtin_fmaf(s2, qs, 512.0f); }
__device__ __forceinline__ int t_bin(float t) { int bi = (int)t; bi = bi < 0 ? 0 : (bi > 1023 ? 1023 : bi); return bi; }

constexpr int SEG_CAP = 144;
__device__ __forceinline__ void find_bin(const u32* h, int T, int lane, int& bsel, int& nabove) {
    u32 wd[16]; int tot = 0;
#pragma unroll
    for (int i = 0; i < 4; ++i) { const uint4 v = *(const uint4*)(h + 1008 - 16 * lane + 4 * i); wd[4 * i] = v.x; wd[4 * i + 1] = v.y; wd[4 * i + 2] = v.z; wd[4 * i + 3] = v.w; tot += (int)(v.x + v.y + v.z + v.w); }
    int pre = tot;
    pre += __builtin_amdgcn_update_dpp(0, pre, 0x111, 0xf, 0xf, true); pre += __builtin_amdgcn_update_dpp(0, pre, 0x112, 0xf, 0xf, true);
    pre += __builtin_amdgcn_update_dpp(0, pre, 0x114, 0xf, 0xf, true); pre += __builtin_amdgcn_update_dpp(0, pre, 0x118, 0xf, 0xf, true);
    pre += __builtin_amdgcn_update_dpp(0, pre, 0x142, 0xa, 0xf, false);
    pre += __builtin_amdgcn_update_dpp(0, pre, 0x143, 0xc, 0xf, false);
    const int excl = pre - tot;
    const bool mine = (excl < T) && (pre >= T);
    int found = -1, fab = 0;
    if (mine) {
        int cum = excl;
#pragma unroll
        for (int i = 15; i >= 0; --i) {
            const int cntb = (int)wd[i];
            if (found < 0 && cum + cntb >= T) { found = 1008 - 16 * lane + i; fab = cum; }
            cum += cntb;
        }
    }
    const unsigned long long bm = __ballot(mine);
    if (bm) { const int srcl = __ffsll((long long)bm) - 1; bsel = __shfl(found, srcl); nabove = __shfl(fab, srcl); }
    else { bsel = -1; nabove = __shfl(pre, 63); }
}
__device__ __forceinline__ void select_load_q(const Params& P, int b, int n16, h8 (&qf)[8][2], float (&wv)[8]) {
    const int lane = threadIdx.x & 63, l15 = lane & 15, g4 = lane >> 4;
    const hf* qi = (const hf*)(P.ws + WS_RC);
    const float* wi = (const float*)(P.ws + WS_WI);
    const size_t qrow = (size_t)b * SEQ + n16 * 16 + l15;
#pragma unroll
    for (int h = 0; h < 8; ++h) {
        qf[h][0] = *(const h8*)(qi + qrow * 512 + h * 64 + g4 * 8);
        qf[h][1] = *(const h8*)(qi + qrow * 512 + h * 64 + 32 + g4 * 8);
        wv[h] = wi[qrow * 8 + h];
    }
}
__device__ __forceinline__ void select_item(const Params& P, int b, int n16, bool has_next, int n16_next, char* smem, h8 (&qf)[8][2], float (&wv)[8]) {
    const int tid = threadIdx.x, lane = tid & 63, w = tid >> 6, l15 = lane & 15, g4 = lane >> 4;
    unsigned char* ws = P.ws;
    const hf* qi = (const hf*)(ws + WS_RC);
    const hf* kib = (const hf*)(ws + WS_KI) + (size_t)b * SEQ * 64;
    const float* wi = (const float*)(ws + WS_WI);
    u16* lists = (u16*)(ws + WS_LIST);
    int* cnts = (int*)(ws + WS_CNT);
    u32* hist = (u32*)smem;
    const int t0 = n16 * 16;
    const int ksplit = w;
    const int tq = t0 + l15;
    const int ql = l15;
    float qscale;
    {
        float w2 = 0.f;
#pragma unroll
        for (int h = 0; h < 8; ++h) w2 = __builtin_fmaf(wv[h], wv[h], w2);
        qscale = 8.0f / fmaxf(sqrtf(w2), 1e-6f);
    }
    float* qsc = (float*)(smem + 143360 + 768);
    if (ksplit == 0 && g4 == 0) qsc[ql] = qscale;
    h8 qlin[2];
    {
        float sl[2][8];
#pragma unroll
        for (int k = 0; k < 2; ++k)
#pragma unroll
            for (int e = 0; e < 8; ++e) sl[k][e] = 0.f;
#pragma unroll
        for (int h = 0; h < 8; ++h) {
#pragma unroll
            for (int k = 0; k < 2; ++k)
#pragma unroll
                for (int e = 0; e < 8; ++e) sl[k][e] = __builtin_fmaf(wv[h], (float)qf[h][k][e], sl[k][e]);
            __builtin_amdgcn_sched_barrier(0);
        }
#pragma unroll
        for (int k = 0; k < 2; ++k)
#pragma unroll
            for (int e = 0; e < 8; ++e) qlin[k][e] = (hf)sl[k][e];
    }
    const int ktd = t0 >> 4;
    const int nmine = (ktd - ksplit + 8) >> 3;
    const unsigned koff = (unsigned)(l15 * 128 + g4 * 16);
    h8 ka[3][2];
#define KI_ISSUE(slot, j) do { int kt_ = ksplit + 8 * (j); kt_ = kt_ > ktd ? ktd : kt_; const unsigned o_ = koff + (unsigned)kt_ * 2048u; ka[slot][0] = *(const h8*)((const char*)kib + o_); ka[slot][1] = *(const h8*)((const char*)kib + o_ + 64u); } while (0)
    float* seg_s = (float*)smem;
    u16* seg_i = (u16*)(smem + 73728);
    u32* whist = (u32*)(smem + 110592) + w * 1024;
    int* blo = (int*)(smem + 143360);
    int* segcnt = (int*)(smem + 143360 + 128);
    int* okflag = (int*)(smem + 143360 + 640);
    for (int attempt = (t0 + 16 <= 1024) ? 1 : 0; attempt < 2; ++attempt) {
        const int step = attempt == 0 ? 8 : 1;
        for (int i = tid; i < 4096; i += NTHR) ((uint4*)hist)[i] = make_uint4(0u, 0u, 0u, 0u);
        if (tid == 0) *okflag = 1;
        __syncthreads();
        if (nmine > 0) KI_ISSUE(0, 0);
        for (int j0 = 0; j0 < nmine; j0 += 2 * step) {
#pragma unroll
            for (int u = 0; u < 2; ++u) {
                const int j = j0 + u * step;
                KI_ISSUE((u + 1) & 1, j + step);
                __builtin_amdgcn_sched_barrier(0);
                if (j < nmine) {
                    const int kt = ksplit + 8 * j;
                    float sc[4];
                    idx_scores(qf, qlin, wv, ka[u][0], ka[u][1], sc);
                    if (kt < ktd) {
#pragma unroll
                        for (int r = 0; r < 4; ++r) atomicAdd(&hist[ql * 1024 + t_bin(score_t(sc[r], qscale))], 1u);
                    } else {
#pragma unroll
                        for (int r = 0; r < 4; ++r) { const int key = kt * 16 + 4 * g4 + r; if (key <= tq) atomicAdd(&hist[ql * 1024 + t_bin(score_t(sc[r], qscale))], 1u); }
                    }
                }
                __builtin_amdgcn_sched_barrier(0);
            }
        }
        __syncthreads();
        for (int qq = 0; qq < 2; ++qq) {
            const int q = w * 2 + qq, nq = t0 + q + 1;
            int ns = 0;
            {
                const u32* hq = hist + q * 1024 + lane * 16;
#pragma unroll
                for (int i = 0; i < 4; ++i) { const uint4 v = *(const uint4*)(hq + 4 * i); ns += (int)(v.x + v.y + v.z + v.w); }
                ns += __builtin_amdgcn_update_dpp(0, ns, 0x111, 0xf, 0xf, true); ns += __builtin_amdgcn_update_dpp(0, ns, 0x112, 0xf, 0xf, true);
                ns += __builtin_amdgcn_update_dpp(0, ns, 0x114, 0xf, 0xf, true); ns += __builtin_amdgcn_update_dpp(0, ns, 0x118, 0xf, 0xf, true);
                ns += __builtin_amdgcn_update_dpp(0, ns, 0x142, 0xa, 0xf, false); ns += __builtin_amdgcn_update_dpp(0, ns, 0x143, 0xc, 0xf, false);
                ns = __builtin_amdgcn_readlane(ns, 63);
            }
            int T;
            if (attempt == 1) T = nq < 256 ? nq : 256;
            else { const float base = 256.0f * (float)ns / (float)nq; T = (int)(base + 4.5f * sqrtf(base) + 3.0f); }
            int bsel, nabove;
            find_bin(hist + q * 1024, T, lane, bsel, nabove);
            if (lane == 0) blo[q] = bsel < 0 ? 0 : bsel;
        }
        __syncthreads();
        int mycnt = 0;
        {
            const int bl = blo[ql];
            const float thr = (bl <= 0) ? -3.0e38f : ((float)bl - 512.0f) / qscale;
            float* mys = seg_s + (ql * 8 + ksplit) * SEG_CAP;
            u16* myi = seg_i + (ql * 8 + ksplit) * SEG_CAP;
            const unsigned long long colmask = 0x0001000100010001ULL << l15;
            if (nmine > 0) { KI_ISSUE(0, 0); KI_ISSUE(1, 1); }
            for (int j0 = 0; j0 < nmine; j0 += 3) {
#pragma unroll
                for (int u = 0; u < 3; ++u) {
                    const int j = j0 + u;
                    KI_ISSUE((u + 2) % 3, j + 2);
                    __builtin_amdgcn_sched_barrier(0);
                    if (j < nmine) {
                        const int kt = ksplit + 8 * j;
                        float sc[4];
                        idx_scores(qf, qlin, wv, ka[u][0], ka[u][1], sc);
#define SEL_ROW(SELEXPR) do { const bool sel = (SELEXPR); const unsigned long long bm = __ballot(sel) & colmask; \
                            const int pos = mycnt + (int)__builtin_amdgcn_mbcnt_hi((unsigned)(bm >> 32), __builtin_amdgcn_mbcnt_lo((unsigned)bm, 0u)); \
                            if (sel && pos < SEG_CAP) { mys[pos] = sc[r]; myi[pos] = (u16)(kt * 16 + 4 * g4 + r); } \
                            mycnt += __popcll(bm); } while (0)
                        if (kt < ktd) {
#pragma unroll
                            for (int r = 0; r < 4; ++r) SEL_ROW(sc[r] >= thr);
                        } else {
#pragma unroll
                            for (int r = 0; r < 4; ++r) SEL_ROW((kt * 16 + 4 * g4 + r <= tq) && (sc[r] >= thr));
                        }
#undef SEL_ROW
                    }
                    __builtin_amdgcn_sched_barrier(0);
                }
            }
            if (g4 == 0) segcnt[ql * 8 + ksplit] = mycnt < SEG_CAP ? mycnt : SEG_CAP;
            if (mycnt > SEG_CAP) *okflag = 0;
        }
        __syncthreads();
        if (tid < 16) { const int nq = t0 + tid + 1; int c = 0;
#pragma unroll
            for (int s = 0; s < 8; ++s) c += segcnt[tid * 8 + s];
            if (c < (nq < 256 ? nq : 256)) *okflag = 0; }
        __syncthreads();
        const int ok = *okflag;
        __syncthreads();
        if (ok) break;
    }
#undef KI_ISSUE
    if (has_next) select_load_q(P, b, n16_next, qf, wv);
    for (int qq = 0; qq < 2; ++qq) {
        const int q = w * 2 + qq, t = t0 + q, nq = t + 1;
        const float qs_q = qsc[q];
        int cs[8];
#pragma unroll
        for (int s = 0; s < 8; ++s) cs[s] = __builtin_amdgcn_readfirstlane(segcnt[q * 8 + s]);
#pragma unroll
        for (int i = 0; i < 4; ++i) *(uint4*)(whist + lane * 16 + 4 * i) = make_uint4(0u, 0u, 0u, 0u);
        WAVE_ORDER();
        float sv[8]; int kv_[8];
#pragma unroll
        for (int s = 0; s < 8; ++s) {
            const bool act = lane < cs[s];
            sv[s] = act ? seg_s[(q * 8 + s) * SEG_CAP + lane] : 0.f; kv_[s] = act ? (int)seg_i[(q * 8 + s) * SEG_CAP + lane] : 0;
        }
#pragma unroll
        for (int s = 0; s < 8; ++s) if (lane < cs[s]) atomicAdd(&whist[t_bin(score_t(sv[s], qs_q))], 1u);
#pragma unroll
        for (int s = 0; s < 8; ++s)
            for (int i = lane + 64; i < cs[s]; i += 64) atomicAdd(&whist[t_bin(score_t(seg_s[(q * 8 + s) * SEG_CAP + i], qs_q))], 1u);
        WAVE_ORDER();
        const int T = nq < 256 ? nq : 256;
        int bstar, nabove;
        find_bin(whist, T, lane, bstar, nabove);
        const int nd = T - nabove;
        WAVE_ORDER();
        u16* lp = lists + ((size_t)b * SEQ + t) * 256;
        float* tie_s = (float*)whist; int* tie_i = (int*)whist + 128;
        int base = 0, ntie = 0;
#define EMIT_CHUNK(ACT, SCV, KEY) do { const bool act = (ACT); const float scv = (SCV); const int key = (KEY); \
                const int bi = t_bin(score_t(scv, qs_q)); \
                const bool sel = act && bi > bstar, tie = act && bi == bstar; \
                const unsigned long long bm = __ballot(sel), bt = __ballot(tie); \
                const int pos = base + (int)__builtin_amdgcn_mbcnt_hi((unsigned)(bm >> 32), __builtin_amdgcn_mbcnt_lo((unsigned)bm, 0u)); \
                const int tp = ntie + (int)__builtin_amdgcn_mbcnt_hi((unsigned)(bt >> 32), __builtin_amdgcn_mbcnt_lo((unsigned)bt, 0u)); \
                if (sel && pos < 256) lp[pos] = (u16)key; \
                if (tie && tp < CAND_CAP) { tie_s[tp] = scv; tie_i[tp] = key; } \
                base += __popcll(bm); ntie += __popcll(bt); } while (0)
#pragma unroll
        for (int s = 0; s < 8; ++s) EMIT_CHUNK(lane < cs[s], sv[s], kv_[s]);
#pragma unroll
        for (int s = 0; s < 8; ++s)
            for (int i0 = 64; i0 < cs[s]; i0 += 64) {
                const int i = i0 + lane; const bool act = i < cs[s];
                const float scv = act ? seg_s[(q * 8 + s) * SEG_CAP + i] : 0.f; const int key = act ? (int)seg_i[(q * 8 + s) * SEG_CAP + i] : 0;
                const int bi = t_bin(score_t(scv, qs_q));
                const bool sel = act && bi > bstar, tie = act && bi == bstar;
                const unsigned long long bm = __ballot(sel), bt = __ballot(tie);
                const int pos = base + (int)__builtin_amdgcn_mbcnt_hi((unsigned)(bm >> 32), __builtin_amdgcn_mbcnt_lo((unsigned)bm, 0u));
                const int tp = ntie + (int)__builtin_amdgcn_mbcnt_hi((unsigned)(bt >> 32), __builtin_amdgcn_mbcnt_lo((unsigned)bt, 0u));
                if (sel && pos < 256) lp[pos] = (u16)key;
                if (tie && tp < CAND_CAP) { tie_s[tp] = scv; tie_i[tp] = key; }
                base += __popcll(bm); ntie += __popcll(bt);
            }
        WAVE_ORDER();
        const int nc = ntie < CAND_CAP ? ntie : CAND_CAP;
        if (nc > 0 && nd > 0) {
            const float s0 = (lane < nc) ? tie_s[lane] : -3.0e38f; const int i0 = (lane < nc) ? tie_i[lane] : 0x7fffffff;
            const float s1 = (lane + 64 < nc) ? tie_s[64 + lane] : -3.0e38f; const int i1 = (lane + 64 < nc) ? tie_i[64 + lane] : 0x7fffffff;
            int r0 = 0, r1 = 0;
            const int n0 = nc < 64 ? nc : 64;
            for (int j = 0; j < n0; ++j) {
                const float sj = __builtin_bit_cast(float, __builtin_amdgcn_readlane(__builtin_bit_cast(int, s0), j)); const int ij = __builtin_amdgcn_readlane(i0, j);
                r0 += (sj > s0 || (sj == s0 && ij < i0)) ? 1 : 0; r1 += (sj > s1 || (sj == s1 && ij < i1)) ? 1 : 0;
            }
            for (int j = 64; j < nc; ++j) {
                const float sj = __builtin_bit_cast(float, __builtin_amdgcn_readlane(__builtin_bit_cast(int, s1), j - 64)); const int ij = __builtin_amdgcn_readlane(i1, j - 64);
                r0 += (sj > s0 || (sj == s0 && ij < i0)) ? 1 : 0; r1 += (sj > s1 || (sj == s1 && ij < i1)) ? 1 : 0;
            }
            if (lane < nc && r0 < nd && base + r0 < 256) lp[base + r0] = (u16)i0;
            if (lane + 64 < nc && r1 < nd && base + r1 < 256) lp[base + r1] = (u16)i1;
        }
        if (lane == 0) { const int tot = base + (nd < nc ? nd : nc); cnts[(size_t)b * SEQ + t] = tot < 256 ? tot : 256; }
        WAVE_ORDER();
    }
    __syncthreads();
}

__device__ __forceinline__ void dsa_attn_phase(const Params& P, char* smem) {
    const int tid = threadIdx.x, lane = tid & 63, w = tid >> 6, l15 = lane & 15, g4 = lane >> 4;
    unsigned char* ws = P.ws;
    const unsigned char* q8 = ws + WS_RA;
    const unsigned char* k8 = ws + WS_RB + 64 * MiB;
    const unsigned char* v8 = ws + WS_V1;
    const hf* sg1 = (const hf*)(ws + WS_RB + 32 * MiB);
    hf* att = (hf*)(ws + WS_RB);
    const u16* lists = (const u16*)(ws + WS_LIST);
    const int* cnts = (const int*)(ws + WS_CNT);
    unsigned char* sBkt = (unsigned char*)smem;
    float* sRb = (float*)(smem + 8192);
    u16* sL = (u16*)(smem + 9216 + w * 512);
    float* sBT = (float*)(smem + 9216 + 8192 + w * 4096);
    unsigned char* sVw = (unsigned char*)smem + 50176 + w * 4608;
    unsigned char* sKw = (unsigned char*)smem + 87040 + w * 4608;
    const int kw_off = (lane >> 3) * 144 + (lane & 7) * 16, kr_off = l15 * 144 + g4 * 16;
    for (int i = tid; i < 2048; i += NTHR) ((u32*)sBkt)[i] = ((const u32*)(ws + WS_TAB + TAB_BKT))[i];
    if (tid < 256) sRb[tid] = P.in[1][tid];
    __syncthreads();
    const int n = l15;
    const int bpa = 4 * (4 * l15 + g4);
    long sel[2];
    {
        unsigned long long s0 = 0ull, s1 = 0ull;
#pragma unroll
        for (int j = 0; j < 8; ++j) { if (8 * g4 + j == l15) s0 |= 0x38ull << (8 * j); if (8 * g4 + j == 16 + l15) s1 |= 0x38ull << (8 * j); }
        sel[0] = (long)s0; sel[1] = (long)s1;
    }
    unsigned* qctr = (unsigned*)(ws + WS_BAR) + 3584;
    const int xg0 = (int)(xb_xcc_id() & 7u);
    u16* sLb[2] = {sL, sL + 2048};
    for (int gi = 0; gi < 8; ++gi) {
    const int xg = (xg0 + gi) & 7;
    const int b = xg >> 2, kv = (xg >> 1) & 1, half = xg & 1;
    const int h = kv * 4 + (n & 3);
    const unsigned char* kvg = v8 + (size_t)(b * 2 + kv) * SEQ * 256;
    const unsigned koff8 = (unsigned)((lane & 7) * 16);
    const unsigned char* kbase = kvg + koff8;
    const unsigned char* vbase = kbase + 128;
    int icur = 0;
    if (lane == 0) icur = (int)__hip_atomic_fetch_add(qctr + 64 * xg, 1u, __ATOMIC_RELAXED, __HIP_MEMORY_SCOPE_AGENT);
    icur = __builtin_amdgcn_readfirstlane(icur);
    int cnt = 0, buf = 0;
    if (icur < 4096) {
        const size_t row0 = (size_t)b * SEQ + 2 * icur + half;
        cnt = cnts[row0];
        const unsigned long long lv = *(const unsigned long long*)(lists + row0 * 256 + lane * 4);
#pragma unroll
        for (int j = 0; j < 4; ++j) sLb[0][lane * 4 + j] = (lane * 4 + j < cnt) ? (u16)(lv >> (16 * j)) : (u16)0;
    }
    LDS_FENCE();
    l2 kb[7][2]; l2 qa = (l2){0, 0}, qb = (l2){0, 0};
#define K_ISSUE_L(L, slot, c) do { const int ia_ = (L)[(c) * 16 + (lane >> 3)], ib_ = (L)[(c) * 16 + 8 + (lane >> 3)]; \
            kb[slot][0] = *(const l2*)(kvg + (koff8 + ((unsigned)ia_ << 8))); kb[slot][1] = *(const l2*)(kvg + (koff8 + ((unsigned)ib_ << 8))); } while (0)
    if (icur < 4096) {
        K_ISSUE_L(sLb[0], 0, 0); K_ISSUE_L(sLb[0], 1, 1);
        { const unsigned char* qp = q8 + ((size_t)b * SEQ + 2 * icur + half) * 1024 + h * 128 + g4 * 16; qa = *(const l2*)qp; qb = *(const l2*)(qp + 64); }
    }
    while (icur < 4096) {
        const u16* sLc = buf ? sLb[1] : sLb[0];
        u16* sLn = buf ? sLb[0] : sLb[1];
        const int t = 2 * icur + half;
        const size_t row = (size_t)b * SEQ + t;
        int inxt = 0;
        if (lane == 0) inxt = (int)__hip_atomic_fetch_add(qctr + 64 * xg, 1u, __ATOMIC_RELAXED, __HIP_MEMORY_SCOPE_AGENT);
        f4 s[4];
        long qm[4][4];
#pragma unroll
        for (int j = 0; j < 4; ++j) {
            const bool mine = (n >> 2) == j;
            qm[j][0] = mine ? qa[0] : 0L; qm[j][1] = mine ? qa[1] : 0L; qm[j][2] = mine ? qb[0] : 0L; qm[j][3] = mine ? qb[1] : 0L;
        }
#define K_ISSUE(slot, c) K_ISSUE_L(sLc, slot, c)
        K_ISSUE(2, 2); K_ISSUE(3, 3); K_ISSUE(4, 4); K_ISSUE(5, 5);
        __builtin_amdgcn_sched_barrier(0);
        {
            const u16* lq = sLc + lane * 4;
            int bk[4];
#pragma unroll
            for (int j = 0; j < 4; ++j) bk[j] = sBkt[t - (int)lq[j]];
            f4 bv[4];
#pragma unroll
            for (int j = 0; j < 4; ++j) bv[j] = *(const f4*)(sRb + bk[j] * 8 + kv * 4) * 1.4426950408889634f;
#pragma unroll
            for (int hh = 0; hh < 4; ++hh) *(f4*)(sBT + hh * 256 + lane * 4) = (f4){bv[0][hh], bv[1][hh], bv[2][hh], bv[3][hh]};
        }
        LDS_FENCE();
        __builtin_amdgcn_sched_barrier(0);
#pragma unroll
        for (int c2 = 0; c2 < 8; ++c2) {
            const int c = 2 * c2;
            if (c + 6 < 16) K_ISSUE((c + 6) % 7, c + 6);
            __builtin_amdgcn_sched_barrier(0);
            *(l2*)(sKw + kw_off) = kb[c % 7][0]; *(l2*)(sKw + kw_off + 8 * 144) = kb[c % 7][1];
            *(l2*)(sKw + 2304 + kw_off) = kb[(c + 1) % 7][0]; *(l2*)(sKw + 2304 + kw_off + 8 * 144) = kb[(c + 1) % 7][1];
            LDS_FENCE();
            if (c + 7 < 16) K_ISSUE((c + 7) % 7, c + 7);
            const l2 ka0 = *(const l2*)(sKw + kr_off), kb0 = *(const l2*)(sKw + kr_off + 64);
            const l2 ka1 = *(const l2*)(sKw + 2304 + kr_off), kb1 = *(const l2*)(sKw + 2304 + kr_off + 64);
            LDS_FENCE();
            f4 a = (c & 3) ? s[c >> 2] : (f4){0.f, 0.f, 0.f, 0.f};
            a = __builtin_amdgcn_mfma_f32_16x16x32_fp8_fp8(ka0[0], qm[c & 3][0], a, 0, 0, 0);
            a = __builtin_amdgcn_mfma_f32_16x16x32_fp8_fp8(ka0[1], qm[c & 3][1], a, 0, 0, 0);
            a = __builtin_amdgcn_mfma_f32_16x16x32_fp8_fp8(kb0[0], qm[c & 3][2], a, 0, 0, 0);
            a = __builtin_amdgcn_mfma_f32_16x16x32_fp8_fp8(kb0[1], qm[c & 3][3], a, 0, 0, 0);
            a = __builtin_amdgcn_mfma_f32_16x16x32_fp8_fp8(ka1[0], qm[(c & 3) + 1][0], a, 0, 0, 0);
            a = __builtin_amdgcn_mfma_f32_16x16x32_fp8_fp8(ka1[1], qm[(c & 3) + 1][1], a, 0, 0, 0);
            a = __builtin_amdgcn_mfma_f32_16x16x32_fp8_fp8(kb1[0], qm[(c & 3) + 1][2], a, 0, 0, 0);
            a = __builtin_amdgcn_mfma_f32_16x16x32_fp8_fp8(kb1[1], qm[(c & 3) + 1][3], a, 0, 0, 0);
            s[c >> 2] = a;
            __builtin_amdgcn_sched_barrier(0);
        }
#undef K_ISSUE
        l2 vb[3][2][2];
#define V_ISSUE(slot, k2) do { _Pragma("unroll") for (int tl = 0; tl < 2; ++tl) { const int ia_ = sLc[(k2) * 32 + tl * 16 + (lane >> 3)], ib_ = sLc[(k2) * 32 + tl * 16 + 8 + (lane >> 3)]; \
            vb[slot][tl][0] = *(const l2*)(kvg + (koff8 + 128u + ((unsigned)ia_ << 8))); vb[slot][tl][1] = *(const l2*)(kvg + (koff8 + 128u + ((unsigned)ib_ << 8))); } } while (0)
        V_ISSUE(0, 0); V_ISSUE(1, 1);
        inxt = __builtin_amdgcn_readfirstlane(inxt);
        int ncnt = 0; unsigned long long nlv = 0ull;
        if (inxt < 4096) { const size_t rown = (size_t)b * SEQ + 2 * inxt + half; ncnt = cnts[rown]; nlv = *(const unsigned long long*)(lists + rown * 256 + lane * 4); }
        __builtin_amdgcn_sched_barrier(0);
        const int myj = n >> 2;
        if (cnt != 256) {
#pragma unroll
            for (int ci = 0; ci < 4; ++ci)
#pragma unroll
                for (int r = 0; r < 4; ++r) s[ci][r] = ((4 * ci + myj) * 16 + 4 * g4 + r < cnt) ? s[ci][r] : -3.0e38f;
        }
        float m = -3.0e38f;
#pragma unroll
        for (int ci = 0; ci < 4; ++ci) {
            const f4 bb = *(const f4*)(sBT + (n & 3) * 256 + (4 * ci + myj) * 16 + 4 * g4);
#pragma unroll
            for (int r = 0; r < 4; ++r) { const float v = __builtin_fmaf(s[ci][r], 0.12751743074602467f, bb[r]); s[ci][r] = v; m = fmaxf(m, v); }
        }
        m = fmaxf(m, __builtin_bit_cast(float, __builtin_amdgcn_update_dpp(0, __builtin_bit_cast(int, m), 0x124, 0xf, 0xf, false)));
        m = fmaxf(m, __builtin_bit_cast(float, __builtin_amdgcn_update_dpp(0, __builtin_bit_cast(int, m), 0x128, 0xf, 0xf, false)));
        m = fmaxf(m, __shfl_xor(m, 16)); m = fmaxf(m, __shfl_xor(m, 32));
        float sum = 0.f;
        int p4[4];
#pragma unroll
        for (int ci = 0; ci < 4; ++ci) {
            float p[4];
#pragma unroll
            for (int r = 0; r < 4; ++r) { p[r] = __builtin_amdgcn_exp2f(s[ci][r] - m); sum += p[r]; }
            int lo = __builtin_amdgcn_cvt_pk_fp8_f32(p[0], p[1], 0, false); lo = __builtin_amdgcn_cvt_pk_fp8_f32(p[2], p[3], lo, true);
            p4[ci] = lo;
        }
        sum += __builtin_bit_cast(float, __builtin_amdgcn_update_dpp(0, __builtin_bit_cast(int, sum), 0x124, 0xf, 0xf, false));
        sum += __builtin_bit_cast(float, __builtin_amdgcn_update_dpp(0, __builtin_bit_cast(int, sum), 0x128, 0xf, 0xf, false));
        sum += __shfl_xor(sum, 16); sum += __shfl_xor(sum, 32);
        long pq[8];
#pragma unroll
        for (int k2 = 0; k2 < 8; ++k2) {
            const int src_ = p4[k2 >> 1];
            const int lo = (k2 & 1) ? __builtin_amdgcn_update_dpp(0, src_, 0x108, 0xf, 0xf, true) : src_;
            const int hi = (k2 & 1) ? __builtin_amdgcn_update_dpp(0, src_, 0x10C, 0xf, 0xf, true) : __builtin_amdgcn_update_dpp(0, src_, 0x104, 0xf, 0xf, true);
            pq[k2] = (long)(((unsigned long long)(unsigned)hi << 32) | (unsigned)lo);
        }
        const float inv = 1.0f / sum;
        f4 o[8];
#pragma unroll
        for (int mt = 0; mt < 8; ++mt) o[mt] = (f4){0.f, 0.f, 0.f, 0.f};
        __builtin_amdgcn_sched_barrier(0);
        V_ISSUE(2, 2);
        h4 sgv[8];
#pragma unroll
        for (int db = 0; db < 8; ++db) sgv[db] = *(const h4*)(sg1 + row * 1024 + h * 128 + db * 16 + 4 * g4);
        __builtin_amdgcn_sched_barrier(0);
        const int vw_off = (lane >> 3) * 144 + (lane & 7) * 16;
        const int tr_r = (lane & 15) >> 1;
        const int vr_off = ((tr_r < 4) ? (4 * g4 + tr_r) : (16 + 4 * g4 + tr_r - 4)) * 144 + 8 * (lane & 1);
#pragma unroll
        for (int k2 = 0; k2 < 8; ++k2) {
            const int slot = k2 % 3;
            __builtin_amdgcn_sched_barrier(0);
#pragma unroll
            for (int tl = 0; tl < 2; ++tl) { *(l2*)(sVw + tl * 2304 + vw_off) = vb[slot][tl][0]; *(l2*)(sVw + tl * 2304 + 8 * 144 + vw_off) = vb[slot][tl][1]; }
            LDS_FENCE();
#pragma unroll
            for (int db = 0; db < 8; ++db) {
                typedef int i2v __attribute__((ext_vector_type(2)));
                const i2v vt = __builtin_amdgcn_ds_read_tr8_b64_v2i32((LAS i2v*)(sVw + vr_off + db * 16));
                o[db] = __builtin_amdgcn_mfma_f32_16x16x32_fp8_fp8(__builtin_bit_cast(long, vt), pq[k2], o[db], 0, 0, 0);
            }
            LDS_FENCE();
            if (k2 + 3 < 8) { V_ISSUE(slot, k2 + 3); }
            __builtin_amdgcn_sched_barrier(0);
        }
#undef V_ISSUE
        if (n < 4) {
#pragma unroll
            for (int db = 0; db < 8; ++db) {
                h4 ov;
#pragma unroll
                for (int r = 0; r < 4; ++r) ov[r] = (hf)(o[db][r] * inv * (float)sgv[db][r]);
                *(h4*)(att + row * 1024 + h * 128 + db * 16 + 4 * g4) = ov;
            }
        }
#pragma unroll
        for (int j = 0; j < 4; ++j) sLn[lane * 4 + j] = (lane * 4 + j < ncnt) ? (u16)(nlv >> (16 * j)) : (u16)0;
        LDS_FENCE();
        if (inxt < 4096) {
            K_ISSUE_L(sLn, 0, 0); K_ISSUE_L(sLn, 1, 1);
            { const unsigned char* qp = q8 + ((size_t)b * SEQ + 2 * inxt + half) * 1024 + h * 128 + g4 * 16; qa = *(const l2*)qp; qb = *(const l2*)(qp + 64); }
        }
        icur = inxt; cnt = ncnt; buf ^= 1;
    }
#undef K_ISSUE_L
    }
    __syncthreads();
}

__global__ void __launch_bounds__(NTHR, 2) mega_fwd(Params P) {
    extern __shared__ __attribute__((aligned(16))) char smem[];
    unsigned char* ws = P.ws;
    const int lo = P.ph_lo, hi = P.ph_hi;
    LAS unsigned char* lds = (LAS unsigned char*)smem;
#if ONE_LAUNCH
    volatile LAS unsigned* st = (volatile LAS unsigned*)(smem + LDS_BYTES - 16);
    if (threadIdx.x == 0) { st[0] = 0u; st[1] = 0u; }
    __syncthreads();
    XcdBarrier bar = xcd_barrier_post((unsigned*)(ws + WS_BAR), st);
#define GRID_BAR() xcd_barrier(bar)
#else
#define GRID_BAR() do {} while (0)
#endif
#define IN(k) (lo <= (k) && (k) < hi)
#define SEAM(k) do { if (IN(k) && IN((k) + 1)) GRID_BAR(); } while (0)
#define PH_BEGIN(k) if (IN(k)) { for (int rep = 0; rep < (((k) == REP_PHASE) ? 1 + REP_N : 1); ++rep) {
#define PH_END(k) __syncthreads(); } } SEAM(k);
    PH_BEGIN(0) p0_prep(P, smem); PH_END(0)
    PH_BEGIN(1) { EpiIn0 E{&P}; pg8::gemm_phase(lds, (const hf*)(ws + WS_RA), (const hf*)(ws + WS_WT_IN0), 2048, 1024, E); } __syncthreads(); thin_kv(P, smem); PH_END(1)
    PH_BEGIN(2)
        for (int it = blockIdx.x; it < 256; it += gridDim.x) swa_item(P, it, smem);
        for (int it = blockIdx.x; it < 256; it += gridDim.x) ssm_item<0>(P, it, smem);
    PH_END(2)
    PH_BEGIN(3) carry_scan(P, smem); GRID_BAR(); for (int it = blockIdx.x; it < 256; it += gridDim.x) ssm_item<1>(P, it, smem); __syncthreads(); transpose_range(P, smem, 576, 960); PH_END(3)
    PH_BEGIN(4) { EpiGlu E{&P}; pg8::gemm_phase(lds, (const hf*)(ws + WS_RC), (const hf*)(ws + WS_WT_GLU), 1024, 512, E); } __syncthreads(); transpose_range(P, smem, 960, 2048); PH_END(4)
    PH_BEGIN(5) { EpiOut0 E{&P}; pg8::gemm_phase(lds, (const hf*)(ws + WS_RA), (const hf*)(ws + WS_WT_OUT0), 1024, 1024, E); } PH_END(5)
    PH_BEGIN(6) { EpiIn1 E{&P}; pg8::gemm_phase(lds, (const hf*)(ws + WS_H1), (const hf*)(ws + WS_WT_IN1), 3072, 1024, E); } __syncthreads(); thin_ki(P, smem); PH_END(6)
    PH_BEGIN(7)
        for (int pr = blockIdx.x; pr < 256; pr += gridDim.x) {
            const int b = pr & 1, j = pr >> 1;
            h8 qf[8][2]; float wv[8];
            select_load_q(P, b, 511 - j, qf, wv);
#pragma unroll 1
            for (int s2 = 0; s2 < 4; ++s2) {
                const int n16 = (s2 == 0) ? (511 - j) : (s2 == 1) ? (256 + j) : (s2 == 2) ? (255 - j) : j;
                const int nxt = (s2 == 0) ? (256 + j) : (s2 == 1) ? (255 - j) : j;
                select_item(P, b, n16, s2 < 3, nxt, smem, qf, wv);
            }
        }
    PH_END(7)
    PH_BEGIN(8) dsa_attn_phase(P, smem); PH_END(8)
    PH_BEGIN(9) { EpiOut1 E{&P}; pg8::gemm_phase(lds, (const hf*)(ws + WS_RB), (const hf*)(ws + WS_WT_OUT1), 1024, 1024, E); } PH_END(9)
}

extern "C" void kernel_launch(void* const* d_in, const int* in_sizes, int n_in, void* d_out, int out_size, void* d_ws, size_t ws_size, hipStream_t stream) {
    static int grid = 0;
    if (grid == 0) {
        int dev = 0, cus = 0;
        if (n_in != 22 || out_size != MTOK * DM || ws_size < WS_END) { fprintf(stderr, "kernel_launch: unexpected shapes (n_in %d out %d ws %zu need %zu)\n", n_in, out_size, ws_size, (size_t)WS_END); grid = -1; return; }
        if (hipGetDevice(&dev) != hipSuccess || hipDeviceGetAttribute(&cus, hipDeviceAttributeMultiprocessorCount, dev) != hipSuccess) { grid = -1; return; }
        if (hipFuncSetAttribute((const void*)mega_fwd, hipFuncAttributeMaxDynamicSharedMemorySize, LDS_BYTES) != hipSuccess) { fprintf(stderr, "kernel_launch: hipFuncSetAttribute failed\n"); grid = -1; return; }
        grid = cus;
        if (grid < 8) grid = 8;
    }
    if (grid < 0) return;
    Params p{};
    for (int i = 0; i < 22; ++i) p.in[i] = (const float*)d_in[i];
    p.out = (float*)d_out; p.ws = (unsigned char*)d_ws;
#if ONE_LAUNCH
    (void)hipMemsetAsync((char*)d_ws + WS_BAR, 0, 16384, stream);
    p.ph_lo = 0; p.ph_hi = NPHASE;
    hipLaunchKernelGGL(mega_fwd, dim3(grid), dim3(NTHR), LDS_BYTES, stream, p);
#else
    for (int ph = 0; ph < NPHASE; ++ph) {
        p.ph_lo = ph; p.ph_hi = ph + 1;
        hipLaunchKernelGGL(mega_fwd, dim3(grid), dim3(NTHR), LDS_BYTES, stream, p);
    }
#endif
}
```

```cpp
#include <hip/hip_runtime.h>
#include <stdint.h>
#include <stdio.h>

#ifndef REP_PHASE
#define REP_PHASE -1
#define REP_N 0
#endif
#ifndef SEL_REP_A
#define SEL_REP_A 0
#define SEL_REP_B 0
#define SEL_REP_C 0
#endif
#ifndef ONE_LAUNCH
#define ONE_LAUNCH 1
#endif

typedef _Float16 hf;
typedef _Float16 h8 __attribute__((ext_vector_type(8)));
typedef _Float16 h4 __attribute__((ext_vector_type(4)));
typedef _Float16 h2 __attribute__((ext_vector_type(2)));
typedef float f4 __attribute__((ext_vector_type(4)));
typedef unsigned u32;
typedef unsigned short u16;
typedef long l2 __attribute__((ext_vector_type(2)));
typedef __fp16 fp16x4_t __attribute__((__vector_size__(4 * sizeof(__fp16))));
#define LAS __attribute__((address_space(3)))

constexpr int NTHR = 512;
constexpr int SEQ = 8192, DM = 1024, MTOK = 2 * SEQ;
constexpr int N0 = 2304, N1 = 3144, N1P = 3328;
constexpr int NPHASE = 10;
constexpr int LDS_BYTES = 144 * 1024;

constexpr size_t MiB = 1024 * 1024;
constexpr size_t WS_BAR    = 0;
constexpr size_t WS_WT_IN0 = 64 * 1024;
constexpr size_t WS_WT_OUT0 = WS_WT_IN0 + (size_t)N0 * 1024 * 2;
constexpr size_t WS_WT_GLU = WS_WT_OUT0 + (size_t)1024 * 1024 * 2;
constexpr size_t WS_WT_IN1 = WS_WT_GLU + (size_t)1024 * 512 * 2;
constexpr size_t WS_WT_OUT1 = WS_WT_IN1 + (size_t)N1P * 1024 * 2;
constexpr size_t WS_TAB    = WS_WT_OUT1 + (size_t)1024 * 1024 * 2;
constexpr size_t TAB_AB   = 0;
constexpr size_t TAB_AT   = 16384;
constexpr size_t TAB_DT   = 32768;
constexpr size_t TAB_BBS  = 33792;
constexpr size_t TAB_CRI  = TAB_BBS + 131072;
constexpr size_t TAB_BIAS0 = TAB_CRI + 131072;
constexpr size_t TAB_BKT  = TAB_BIAS0 + 4096;
constexpr size_t TAB_SIZE = 512 * 1024;
constexpr size_t WS_RA = 18 * MiB;
constexpr size_t WS_RB = WS_RA + 32 * MiB;
constexpr size_t WS_RC = WS_RB + 72 * MiB;
constexpr size_t WS_V1 = WS_RC + 16 * MiB;
constexpr size_t WS_KI = WS_V1 + 8 * MiB;
constexpr size_t WS_WI = WS_KI + 2 * MiB;
constexpr size_t WS_LIST = WS_WI + MiB;
constexpr size_t WS_CNT = WS_LIST + 8 * MiB;
constexpr size_t WS_SC = WS_CNT + MiB;
constexpr size_t WS_V0T = WS_SC + 4 * MiB;
constexpr size_t WS_ROWSS = WS_V0T + 4 * MiB;
constexpr size_t WS_CIN = WS_ROWSS + MiB;
constexpr size_t WS_H1 = WS_CIN + 4 * MiB;
constexpr size_t WS_END = WS_H1 + 32 * MiB;

struct Params {
    const float* in[22];
    float* out;
    unsigned char* ws;
    int ph_lo, ph_hi;
};

__device__ __forceinline__ float silu_f(float x) { return x * __builtin_amdgcn_rcpf(1.0f + __expf(-x)); }
__device__ __forceinline__ float sigmoid_f(float x) { return __builtin_amdgcn_rcpf(1.0f + __expf(-x)); }
__device__ __forceinline__ float gelu_tanh_f(float x) {
    const float z = 0.7978845608028654f * (x + 0.044715f * x * x * x);
    const float e = __expf(2.0f * z);
    const float th = 1.0f - 2.0f * __builtin_amdgcn_rcpf(e + 1.0f);
    return 0.5f * x * (1.0f + th);
}
__device__ __forceinline__ float red16(float v) {
    v += __shfl_xor(v, 1); v += __shfl_xor(v, 2); v += __shfl_xor(v, 4); v += __shfl_xor(v, 8); return v;
}
__device__ __forceinline__ unsigned char f2fp8(float v) { return (unsigned char)(__builtin_amdgcn_cvt_pk_fp8_f32(v, v, 0, false) & 0xff); }
__device__ __forceinline__ int fsw(int row) { return (0x78 >> (((row >> 2) & 3) * 2)) & 3; }
#define LDS_FENCE() asm volatile("s_waitcnt lgkmcnt(0)" ::: "memory")
#define WAVE_ORDER() asm volatile("" ::: "memory")

#define XB_TMO      128
#define XB_XCNT(j)  (256  + 64 * (j))
#define XB_XSUB(j)  (1280 + 64 * (j))
#define XB_XGEN(j)  (2304 + 64 * (j))
#define XB_TOP      3328
#define XB_TOPGEN   3392
#define XCD_BAR_WORDS 3456
#define XB_SPIN_CAP (1u << 22)
__device__ __forceinline__ unsigned xb_ld(unsigned* p)              { return __hip_atomic_load(p, __ATOMIC_RELAXED, __HIP_MEMORY_SCOPE_AGENT); }
__device__ __forceinline__ unsigned xb_add(unsigned* p, unsigned v) { return __hip_atomic_fetch_add(p, v, __ATOMIC_RELAXED, __HIP_MEMORY_SCOPE_AGENT); }
__device__ __forceinline__ unsigned xb_xcc_id() { return (unsigned)__builtin_amdgcn_s_getreg((3 << 11) | 20) & 0xFu; }
#define XB_SPIN(cond, bar) do { unsigned _sp = 0; while (cond) { __builtin_amdgcn_s_sleep(1); \
    if ((++_sp & 255u) == 0u) { if (xb_ld(&(bar)[XB_TMO])) break; if (_sp > XB_SPIN_CAP) { atomicAdd(&(bar)[XB_TMO], 1u); break; } } } } while (0)
struct XcdBarrier { unsigned* bar; unsigned x; volatile LAS unsigned* st; };
__device__ __forceinline__ XcdBarrier xcd_barrier_post(unsigned* bar, volatile LAS unsigned* st) {
    XcdBarrier b; b.bar = bar; b.x = xb_xcc_id(); b.st = st;
    if (threadIdx.x == 0) (void)xb_add(&bar[XB_XCNT(b.x)], 1u);
    return b;
}
__device__ __forceinline__ void xcd_barrier_complete(unsigned* bar, unsigned x, unsigned& nloc, unsigned& nx) {
    const unsigned G = gridDim.x;
    unsigned sum, cnt, mine, sp = 0u;
    for (;;) {
        sum = 0u; cnt = 0u; mine = 0u;
#pragma unroll
        for (unsigned j = 0; j < 16; ++j) { const unsigned c = xb_ld(&bar[XB_XCNT(j)]); sum += c; cnt += (c > 0u) ? 1u : 0u; mine = (j == x) ? c : mine; }
        if (sum == G) break;
        __builtin_amdgcn_s_sleep(1);
        if ((++sp & 255u) == 0u) { if (xb_ld(&bar[XB_TMO])) break; if (sp > XB_SPIN_CAP) { atomicAdd(&bar[XB_TMO], 1u); break; } }
    }
    nloc = mine > 0u ? mine : 1u; nx = cnt > 0u ? cnt : 1u;
}
__device__ __forceinline__ void xcd_barrier(const XcdBarrier& b) {
    asm volatile("s_waitcnt vmcnt(0)" ::: "memory");
    __syncthreads();
    if (threadIdx.x == 0) {
        unsigned* bar = b.bar;
        __builtin_amdgcn_s_waitcnt(0);
        unsigned nloc = b.st[0], nx = b.st[1];
        if (nloc == 0u) { xcd_barrier_complete(bar, b.x, nloc, nx); b.st[0] = nloc; b.st[1] = nx; }
        const unsigned old = xb_add(&bar[XB_XSUB(b.x)], 1u);
        const unsigned gen = old / nloc;
        if (old + 1u == (gen + 1u) * nloc) {
            __builtin_amdgcn_fence(__ATOMIC_RELEASE, "agent");
            asm volatile("s_waitcnt vmcnt(0)" ::: "memory");
            const unsigned og = xb_add(&bar[XB_TOP], 1u);
            const unsigned tg = og / nx;
            if (og + 1u == (tg + 1u) * nx) xb_add(&bar[XB_TOPGEN], 1u);
            else XB_SPIN(xb_ld(&bar[XB_TOPGEN]) == tg, bar);
            __builtin_amdgcn_fence(__ATOMIC_ACQUIRE, "agent");
            xb_add(&bar[XB_XGEN(b.x)], 1u);
            asm volatile("s_waitcnt vmcnt(0)" ::: "memory");
        } else {
            XB_SPIN(xb_ld(&bar[XB_XGEN(b.x)]) == gen, bar);
            __builtin_amdgcn_fence(__ATOMIC_ACQUIRE, "agent");
            asm volatile("s_waitcnt vmcnt(0)" ::: "memory");
        }
    }
    __syncthreads();
}

__device__ __forceinline__ void transpose_tile(const float* __restrict__ src, int K, int N, hf* dst, int k0, int n0, int mode, float* tile, const float* __restrict__ ks) {
    const int tid = threadIdx.x;
#pragma unroll
    for (int i = 0; i < 8; ++i) {
        const int kk = (tid >> 6) + 8 * i, nn = tid & 63, n = n0 + nn;
        const float sk = ks ? ks[k0 + kk] : 1.0f;
        tile[kk * 65 + nn] = (n < N) ? src[(size_t)(k0 + kk) * N + n] * sk : 0.0f;
    }
    __syncthreads();
    {
        const int nn = tid >> 3, kc = tid & 7, n = n0 + nn;
        int drow = n;
        if (mode == 1) { const int j = n & 511, half = n >> 9; drow = (j >> 2) * 8 + half * 4 + (j & 3); }
        if (mode == 2) { drow = (n < 512) ? n : ((n < 768) ? (n + 1536) : (n - 256)); }
        h8 v;
#pragma unroll
        for (int j = 0; j < 8; ++j) v[j] = (hf)tile[(kc * 8 + j) * 65 + nn];
        *(h8*)(dst + (size_t)drow * K + k0 + kc * 8) = v;
    }
    __syncthreads();
}

__device__ __forceinline__ void p0_prep(const Params& P, char* smem) {
    const int tid = threadIdx.x, lane = tid & 63, w = tid >> 6;
    unsigned char* ws = P.ws;
    for (int it = blockIdx.x; it < 2048; it += gridDim.x) {
        const float* src; hf* dst; int K, N, ntl, mode = 0, loc; const float* ks = nullptr;
        if (it < 576)       { loc = it;        src = P.in[3];  dst = (hf*)(ws + WS_WT_IN0);  K = 1024; N = N0;   ntl = 36; mode = 2; }
        else if (it < 832)  { loc = it - 576;  src = P.in[4];  dst = (hf*)(ws + WS_WT_OUT0); K = 1024; N = 1024; ntl = 16; }
        else if (it < 960)  { loc = it - 832;  src = P.in[16]; dst = (hf*)(ws + WS_WT_GLU);  K = 512;  N = 1024; ntl = 16; mode = 1; }
        else if (it < 1792) { loc = it - 960;  src = P.in[18]; dst = (hf*)(ws + WS_WT_IN1);  K = 1024; N = N1;   ntl = 52; ks = P.in[2] + DM; }
        else                { loc = it - 1792; src = P.in[19]; dst = (hf*)(ws + WS_WT_OUT1); K = 1024; N = 1024; ntl = 16; }
        const int kt = loc / ntl, nt = loc % ntl;
        transpose_tile(src, K, N, dst, kt * 64, nt * 64, mode, (float*)smem, ks);
    }
    {
        const float* x = P.in[0]; const float* g = P.in[2];
        hf* hn0 = (hf*)(ws + WS_RA);
        f4 gv[4];
#pragma unroll
        for (int i = 0; i < 4; ++i) gv[i] = *(const f4*)(g + i * 256 + lane * 4);
        for (int row = blockIdx.x * 8 + w; row < MTOK; row += gridDim.x * 8) {
            f4 v[4]; float ss = 0.f;
#pragma unroll
            for (int i = 0; i < 4; ++i) { v[i] = *(const f4*)(x + (size_t)row * DM + i * 256 + lane * 4); ss += v[i][0] * v[i][0] + v[i][1] * v[i][1] + v[i][2] * v[i][2] + v[i][3] * v[i][3]; }
#pragma unroll
            for (int o = 1; o < 64; o <<= 1) ss += __shfl_xor(ss, o);
            const float rs = rsqrtf(ss * (1.0f / 1024.0f) + 1e-6f);
#pragma unroll
            for (int i = 0; i < 4; ++i) {
                h4 o; o[0] = (hf)(v[i][0] * rs * gv[i][0]); o[1] = (hf)(v[i][1] * rs * gv[i][1]); o[2] = (hf)(v[i][2] * rs * gv[i][2]); o[3] = (hf)(v[i][3] * rs * gv[i][3]);
                *(h4*)(hn0 + (size_t)row * DM + i * 256 + lane * 4) = o;
            }
        }
    }
    {
        const int gt = blockIdx.x * NTHR + tid;
        if (gt < 2048) {
            const int g = gt >> 6, p = gt & 63;
            const double dt = exp((double)P.in[8][g]);
            const double ar = (double)P.in[9][gt], ai = (double)P.in[10][gt];
            const double mag = exp(ar * dt), ang = ai * dt;
            const double abr = mag * cos(ang), abi = mag * sin(ang);
            const double den = ar * ar + ai * ai;
            const double em1 = expm1(ar * dt);
            const double s2 = sin(0.5 * ang);
            const double nr = em1 * cos(ang) - 2.0 * s2 * s2, ni = abi;
            const double fr = (nr * ar + ni * ai) / den, fi = (ni * ar - nr * ai) / den;
            float* tab_ab = (float*)(ws + WS_TAB + TAB_AB); float* tab_at = (float*)(ws + WS_TAB + TAB_AT);
            tab_ab[gt * 2] = (float)abr; tab_ab[gt * 2 + 1] = (float)abi;
            double pr = abr, pi = abi;
#pragma unroll
            for (int i = 0; i < 6; ++i) { const double nr2 = pr * pr - pi * pi, ni2 = 2.0 * pr * pi; pr = nr2; pi = ni2; }
            tab_at[gt * 2] = (float)pr; tab_at[gt * 2 + 1] = (float)pi;
            if (p == 0) ((float*)(ws + WS_TAB + TAB_DT))[g] = (float)dt;
            hf* bbs = (hf*)(ws + WS_TAB + TAB_BBS); hf* cri = (hf*)(ws + WS_TAB + TAB_CRI);
            const double inv_dt = 1.0 / dt;
            for (int h = 0; h < 16; ++h) {
                const double br = (double)P.in[11][(size_t)gt * 16 + h], bi = (double)P.in[12][(size_t)gt * 16 + h];
                bbs[((size_t)g * 128 + p) * 16 + h]      = (hf)(float)((fr * br - fi * bi) * inv_dt);
                bbs[((size_t)g * 128 + 64 + p) * 16 + h] = (hf)(float)((fr * bi + fi * br) * inv_dt);
                cri[((size_t)g * 16 + h) * 128 + 2 * p]     = (hf)P.in[13][((size_t)g * 16 + h) * 64 + p];
                cri[((size_t)g * 16 + h) * 128 + 2 * p + 1] = (hf)(-P.in[14][((size_t)g * 16 + h) * 64 + p]);
            }
        }
    }
    {
        const int gt = blockIdx.x * NTHR + tid;
        if (gt < 8192) {
            const int d = gt;
            int bk;
            if (d < 16) bk = d;
            else {
                const int thr[15] = {21, 27, 35, 46, 59, 77, 99, 128, 166, 216, 280, 363, 470, 609, 790};
                bk = 16;
#pragma unroll
                for (int i = 0; i < 15; ++i) bk += (d >= thr[i]) ? 1 : 0;
            }
            ((unsigned char*)(ws + WS_TAB + TAB_BKT))[d] = (unsigned char)bk;
            if (d < 128) {
                float* b0 = (float*)(ws + WS_TAB + TAB_BIAS0);
#pragma unroll
                for (int h = 0; h < 8; ++h) b0[h * 128 + d] = P.in[1][bk * 8 + h];
            }
        }
    }
}

namespace pg8 {
constexpr int BM = 256, BK = 64, HALF = 128, HTB = HALF * BK * 2, STAGE_BYTES = 8 * HTB, NXCD = 8, WGM = 8;
__device__ __forceinline__ int lds_byte(int r, int c) { const int st = (r >> 4) * 2 + (c >> 5), rr = r & 15, cc = c & 31, ob = rr * 64 + cc * 2; return st * 1024 + (ob ^ (((ob >> 9) & 1) << 5)); }
__device__ __forceinline__ void stage_rc(int b, int& R, int& C) { const int st = b / 1024, sb = b % 1024, swz = sb ^ (((sb >> 9) & 1) << 5); R = (st >> 1) * 16 + swz / 64; C = (st & 1) * 32 + (swz % 64) / 2; }
__device__ __forceinline__ int perm32(int rho) { const int n = rho >> 4, i = rho & 15; return 8 * (i >> 2) + 4 * n + (i & 3); }
struct Unit { int pm, pn; };
struct StaticOrder {
    int nM, nN, nwg, G, c;
    __device__ void init(int M, int N, int G_, int c_) { nM = M / BM; nN = N / BM; nwg = nM * nN; G = G_; c = c_; }
    __device__ bool next(int i, Unit& u) const {
        const long L = (long)i * G + c; if (L >= nwg) return false;
        int wgid = (int)L; { const int q = nwg / NXCD, r = nwg % NXCD, xcd = wgid % NXCD, off = wgid / NXCD; wgid = (xcd < r ? xcd * (q + 1) : r * (q + 1) + (xcd - r) * q) + off; }
        const int nig = WGM * nN, gid = wgid / nig, fm = gid * WGM, gsz = (nM - fm) < WGM ? (nM - fm) : WGM;
        u.pm = fm + ((wgid % nig) % gsz); u.pn = (wgid % nig) / gsz; return true;
    }
};

template <class Epi>
__device__ __forceinline__ void gemm_phase(LAS unsigned char* lds, const hf* gA, const hf* gBt, int N, int K, const Epi& E) {
    const int tid = threadIdx.x, wid = __builtin_amdgcn_readfirstlane(tid >> 6), lane = tid & 63, wr = wid >> 2, wc = wid & 3, fr = lane & 15, fq = lane >> 4;
    const int nt = K / BK;
    StaticOrder S; S.init(MTOK, N, (int)gridDim.x, (int)blockIdx.x);
    unsigned voffA[2], voffB[2];
#pragma unroll
    for (int i = 0; i < 2; ++i) { int R, C; stage_rc(tid * 16 + i * 8192, R, C); const int Rb = Epi::PERM ? ((R & ~31) + perm32(R & 31)) : R;
        voffA[i] = (unsigned)(R * K + C) * 2u; voffB[i] = (unsigned)(Rb * K + C) * 2u; }
    const size_t kstep = (size_t)(BK * 2);
    const size_t hstep = (size_t)HALF * K * 2;
    const size_t tstep = 2 * hstep;
    const unsigned ldsw = (unsigned)wid * 1024u;
    const int aoff = lds_byte(wr * 64 + fr, fq * 8), boff = lds_byte(wc * 32 + fr, fq * 8);
#define PG8_SA(b, h) (((b) * 2 + (h)) * HTB)
#define PG8_SB(b, h) ((4 + (b) * 2 + (h)) * HTB)
#define PG8_STAGE(bufoff, gbase, voff) do { _Pragma("unroll") for (int _i = 0; _i < 2; ++_i) \
        __builtin_amdgcn_global_load_lds((const unsigned*)((const char*)(gbase) + (voff)[_i]), (LAS unsigned*)(lds + (bufoff) + ldsw + _i * 8192), 16, 0, 0); } while (0)
#define PG8_LDA(dst, b, h) do { _Pragma("unroll") for (int m = 0; m < 4; ++m) _Pragma("unroll") for (int k = 0; k < 2; ++k) dst[m][k] = *(const LAS h8*)(lds + PG8_SA(b, h) + aoff + m * 2048 + k * 1024); } while (0)
#define PG8_LDB(dst, b, h) do { _Pragma("unroll") for (int n = 0; n < 2; ++n) _Pragma("unroll") for (int k = 0; k < 2; ++k) dst[n][k] = *(const LAS h8*)(lds + PG8_SB(b, h) + boff + n * 2048 + k * 1024); } while (0)
#define PG8_MMA(ai, bj, At, Bt) do { __builtin_amdgcn_s_setprio(1); _Pragma("unroll") for (int m = 0; m < 4; ++m) _Pragma("unroll") for (int n = 0; n < 2; ++n) _Pragma("unroll") for (int k = 0; k < 2; ++k) \
        acc[ai][bj][m][n] = __builtin_amdgcn_mfma_f32_16x16x32_f16(Bt[n][k], At[m][k], acc[ai][bj][m][n], 0, 0, 0); __builtin_amdgcn_s_setprio(0); } while (0)
#define PG8_WAIT_V(n) asm volatile("s_waitcnt vmcnt(" #n ")" ::: "memory")
#define PG8_WAIT_L(n) asm volatile("s_waitcnt lgkmcnt(" #n ")" ::: "memory")
#define PG8_BAR __builtin_amdgcn_s_barrier()
#define PG8_SCHED __builtin_amdgcn_sched_barrier(0)
    Unit cur, nxt; int ui = 0;
    if (!S.next(0, cur)) return;
    f4 acc[2][2][4][2];
#pragma unroll
    for (int a = 0; a < 2; ++a)
#pragma unroll
        for (int b = 0; b < 2; ++b)
#pragma unroll
            for (int m = 0; m < 4; ++m)
#pragma unroll
                for (int n = 0; n < 2; ++n) acc[a][b][m][n] = (f4){0.f, 0.f, 0.f, 0.f};
    h8 At[4][2], B0[2][2], B1[2][2];
    const char* cA = (const char*)gA + (size_t)cur.pm * tstep; const char* cB = (const char*)gBt + (size_t)cur.pn * tstep;
    PG8_STAGE(PG8_SB(0, 0), cB, voffB); PG8_STAGE(PG8_SB(0, 1), cB + hstep, voffB); PG8_STAGE(PG8_SA(0, 0), cA, voffA); PG8_STAGE(PG8_SA(0, 1), cA + hstep, voffA);
    if (wr == 1) PG8_BAR;
    PG8_WAIT_V(2); PG8_BAR;
    PG8_STAGE(PG8_SB(1, 0), cB + kstep, voffB); PG8_STAGE(PG8_SA(1, 0), cA + kstep, voffA); PG8_STAGE(PG8_SB(1, 1), cB + hstep + kstep, voffB);
    PG8_WAIT_V(6); PG8_BAR;
    for (;;) {
        const bool has_next = S.next(ui + 1, nxt);
        const char* nA = has_next ? (const char*)gA + (size_t)nxt.pm * tstep : cA; const char* nB = has_next ? (const char*)gBt + (size_t)nxt.pn * tstep : cB;
        for (int t = 0; t < nt; t += 2) {
            const bool last = (t == nt - 2);
            const char* a1 = cA + (size_t)(t + 1) * kstep;
            const char* a2 = last ? nA : cA + (size_t)(t + 2) * kstep; const char* b2 = last ? nB : cB + (size_t)(t + 2) * kstep;
            const char* a3 = a2 + kstep; const char* b3 = b2 + kstep;
            PG8_LDB(B0, 0, 0); PG8_LDB(B1, 0, 1); PG8_SCHED; PG8_LDA(At, 0, 0); PG8_STAGE(PG8_SA(1, 1), a1 + hstep, voffA);
            PG8_WAIT_V(8); PG8_WAIT_L(0); PG8_BAR; PG8_MMA(0, 0, At, B0); PG8_MMA(0, 1, At, B1); PG8_BAR; PG8_SCHED;
            PG8_LDA(At, 0, 1); PG8_STAGE(PG8_SB(0, 0), b2, voffB); PG8_STAGE(PG8_SB(0, 1), b2 + hstep, voffB); PG8_STAGE(PG8_SA(0, 0), a2, voffA);
            PG8_WAIT_V(8); PG8_WAIT_L(0); PG8_BAR; PG8_MMA(1, 0, At, B0); PG8_MMA(1, 1, At, B1); PG8_BAR; PG8_SCHED;
            PG8_LDB(B0, 1, 0); PG8_LDB(B1, 1, 1); PG8_SCHED; PG8_LDA(At, 1, 0); PG8_STAGE(PG8_SA(0, 1), a2 + hstep, voffA);
            PG8_WAIT_V(8); PG8_WAIT_L(0); PG8_BAR; PG8_MMA(0, 0, At, B0); PG8_MMA(0, 1, At, B1); PG8_BAR; PG8_SCHED;
            PG8_LDA(At, 1, 1); PG8_STAGE(PG8_SB(1, 0), b3, voffB); PG8_STAGE(PG8_SB(1, 1), b3 + hstep, voffB); PG8_STAGE(PG8_SA(1, 0), a3, voffA);
            PG8_WAIT_V(8); PG8_WAIT_L(0); PG8_BAR; PG8_MMA(1, 0, At, B0); PG8_MMA(1, 1, At, B1); PG8_BAR; PG8_SCHED;
        }
        if (wr == 0) PG8_BAR;
        E(acc, cur, wr, wc, fr, fq, lds);
        if (!has_next) break;
#pragma unroll
        for (int a = 0; a < 2; ++a)
#pragma unroll
            for (int b = 0; b < 2; ++b)
#pragma unroll
                for (int m = 0; m < 4; ++m)
#pragma unroll
                    for (int n = 0; n < 2; ++n) acc[a][b][m][n] = (f4){0.f, 0.f, 0.f, 0.f};
        cur = nxt; cA = nA; cB = nB; ++ui;
        if (wr == 1) PG8_BAR;
    }
    PG8_WAIT_V(0);
    PG8_BAR;
#undef PG8_SA
#undef PG8_SB
#undef PG8_STAGE
#undef PG8_LDA
#undef PG8_LDB
#undef PG8_MMA
#undef PG8_WAIT_V
#undef PG8_WAIT_L
#undef PG8_BAR
#undef PG8_SCHED
}
}

constexpr int EPI_LDS = 131072;
#define EPI_BAR() do { asm volatile("s_waitcnt lgkmcnt(0)" ::: "memory"); __builtin_amdgcn_s_barrier(); asm volatile("" ::: "memory"); } while (0)
typedef f4 acc_t[2][2][4][2];
__device__ __forceinline__ h8 pack8(const f4& a, const f4& b) { h8 o; o[0] = (hf)a[0]; o[1] = (hf)a[1]; o[2] = (hf)a[2]; o[3] = (hf)a[3]; o[4] = (hf)b[0]; o[5] = (hf)b[1]; o[6] = (hf)b[2]; o[7] = (hf)b[3]; return o; }
__device__ __forceinline__ unsigned long long pack8_fp8(const f4& a, const f4& b) {
    int lo = __builtin_amdgcn_cvt_pk_fp8_f32(a[0], a[1], 0, false); lo = __builtin_amdgcn_cvt_pk_fp8_f32(a[2], a[3], lo, true);
    int hi = __builtin_amdgcn_cvt_pk_fp8_f32(b[0], b[1], 0, false); hi = __builtin_amdgcn_cvt_pk_fp8_f32(b[2], b[3], hi, true);
    return ((unsigned long long)(unsigned)hi << 32) | (unsigned)lo;
}
__device__ __forceinline__ float ss32(const f4& a, const f4& b) {
    float s = a[0] * a[0] + a[1] * a[1] + a[2] * a[2] + a[3] * a[3] + b[0] * b[0] + b[1] * b[1] + b[2] * b[2] + b[3] * b[3];
    s += __shfl_xor(s, 16); s += __shfl_xor(s, 32); return s;
}

struct EpiIn0 {
    static constexpr bool PERM = true;
    const Params* P;
    __device__ __forceinline__ void operator()(acc_t& acc, const pg8::Unit& u, int wr, int wc, int fr, int fq, LAS unsigned char* lds) const {
        hf* z0 = (hf*)(P->ws + WS_RB);
        LAS float* xch = (LAS float*)(lds + EPI_LDS);
        const bool anynorm = (u.pn <= 1);
        if (anynorm) {
#pragma unroll
            for (int bj = 0; bj < 2; ++bj)
#pragma unroll
                for (int ai = 0; ai < 2; ++ai)
#pragma unroll
                    for (int m = 0; m < 4; ++m) {
                        const float s = ss32(acc[ai][bj][m][0], acc[ai][bj][m][1]);
                        if (fq == 0) xch[((wr * 4 + wc) * 2 + bj) * 128 + ai * 64 + m * 16 + fr] = s;
                    }
            EPI_BAR();
        }
#pragma unroll
        for (int bj = 0; bj < 2; ++bj) {
            const int cg = u.pn * 256 + bj * 128;
            const int cb = (cg < 512) ? cg : cg + 256;
            const int col0 = cb + wc * 32 + fq * 8;
            const bool norm = (cb < 512), act = (cb >= 768 && cb < 1280) || (cb >= 1792);
            f4 g0 = (f4){1.f, 1.f, 1.f, 1.f}, g1 = g0;
            if (norm) { const float* gw = P->in[5]; g0 = *(const f4*)(gw + (col0 & 63)); g1 = *(const f4*)(gw + (col0 & 63) + 4); }
#pragma unroll
            for (int ai = 0; ai < 2; ++ai)
#pragma unroll
                for (int m = 0; m < 4; ++m) {
                    const size_t row = (size_t)u.pm * 256 + ai * 128 + wr * 64 + m * 16 + fr;
                    f4 a = acc[ai][bj][m][0], b = acc[ai][bj][m][1];
                    if (norm) {
                        const int ri = ai * 64 + m * 16 + fr;
                        const float tot = xch[((wr * 4 + wc) * 2 + bj) * 128 + ri] + xch[((wr * 4 + (wc ^ 1)) * 2 + bj) * 128 + ri];
                        const float sc = rsqrtf(tot * (1.0f / 64.0f) + 1e-6f);
                        a = a * sc * g0; b = b * sc * g1;
                    } else if (act) {
#pragma unroll
                        for (int e = 0; e < 4; ++e) { a[e] = silu_f(a[e]); b[e] = silu_f(b[e]); }
                    }
                    *(h8*)(z0 + row * N0 + col0) = pack8(a, b);
                }
        }
        if (anynorm) EPI_BAR();
    }
};

struct EpiGlu {
    static constexpr bool PERM = true;
    const Params* P;
    __device__ __forceinline__ void operator()(acc_t& acc, const pg8::Unit& u, int wr, int wc, int fr, int fq, LAS unsigned char* lds) const {
        const hf* z0 = (const hf*)(P->ws + WS_RB); hf* cat = (hf*)(P->ws + WS_RA);
        const float* gb = P->in[17];
        h4 sg[2][2][4];
        f4 ba[2], bb[2];
#pragma unroll
        for (int bj = 0; bj < 2; ++bj) {
            const int j0 = ((u.pn * 256 + bj * 128 + wc * 32 + fq * 8) >> 3) * 4;
            ba[bj] = *(const f4*)(gb + j0); bb[bj] = *(const f4*)(gb + 512 + j0);
#pragma unroll
            for (int ai = 0; ai < 2; ++ai)
#pragma unroll
                for (int m = 0; m < 4; ++m) {
                    const size_t row = (size_t)u.pm * 256 + ai * 128 + wr * 64 + m * 16 + fr;
                    sg[bj][ai][m] = *(const h4*)(z0 + row * N0 + 1792 + j0);
                }
        }
#pragma unroll
        for (int bj = 0; bj < 2; ++bj) {
            const int j0 = ((u.pn * 256 + bj * 128 + wc * 32 + fq * 8) >> 3) * 4;
#pragma unroll
            for (int ai = 0; ai < 2; ++ai)
#pragma unroll
                for (int m = 0; m < 4; ++m) {
                    const size_t row = (size_t)u.pm * 256 + ai * 128 + wr * 64 + m * 16 + fr;
                    const f4 a = acc[ai][bj][m][0] + ba[bj], g = acc[ai][bj][m][1] + bb[bj];
                    h4 o;
#pragma unroll
                    for (int e = 0; e < 4; ++e) o[e] = (hf)(a[e] * sigmoid_f(g[e]) * (float)sg[bj][ai][m][e]);
                    *(h4*)(cat + row * DM + 512 + j0) = o;
                }
        }
    }
};

struct EpiOut0 {
    static constexpr bool PERM = false;
    const Params* P;
    __device__ __forceinline__ void operator()(acc_t& acc, const pg8::Unit& u, int wr, int wc, int fr, int fq, LAS unsigned char* lds) const {
        const float* x = P->in[0];
        hf* h1 = (hf*)(P->ws + WS_H1); float* rowss = (float*)(P->ws + WS_ROWSS);
        const size_t row0 = (size_t)u.pm * 256 + wr * 64 + fr;
        const int colb = u.pn * 256 + wc * 32 + fq * 4;
        f4 xv[2][8];
#define EO0_LOAD(bt, dst) do { _Pragma("unroll") for (int m2 = 0; m2 < 2; ++m2) _Pragma("unroll") for (int bj = 0; bj < 2; ++bj) _Pragma("unroll") for (int n = 0; n < 2; ++n) \
            dst[(m2 * 2 + bj) * 2 + n] = *(const f4*)(x + (row0 + ((bt) >> 1) * 128 + (((bt) & 1) * 2 + m2) * 16) * DM + colb + bj * 128 + n * 16); } while (0)
        EO0_LOAD(0, xv[0]);
#pragma unroll
        for (int bt = 0; bt < 4; ++bt) {
            if (bt + 1 < 4) EO0_LOAD(bt + 1, xv[(bt + 1) & 1]);
            const int ai = bt >> 1;
#pragma unroll
            for (int m2 = 0; m2 < 2; ++m2) {
                const int m = (bt & 1) * 2 + m2;
                const size_t row = row0 + ai * 128 + m * 16;
                float ss = 0.f;
#pragma unroll
                for (int bj = 0; bj < 2; ++bj)
#pragma unroll
                    for (int n = 0; n < 2; ++n) {
                        const int col = colb + bj * 128 + n * 16;
                        const f4 h = xv[bt & 1][(m2 * 2 + bj) * 2 + n] + acc[ai][bj][m][n];
                        h4 o; o[0] = (hf)h[0]; o[1] = (hf)h[1]; o[2] = (hf)h[2]; o[3] = (hf)h[3];
                        *(h4*)(h1 + row * DM + col) = o;
                        const float q0 = (float)o[0], q1 = (float)o[1], q2 = (float)o[2], q3 = (float)o[3];
                        ss += q0 * q0 + q1 * q1 + q2 * q2 + q3 * q3;
                    }
                ss += __shfl_xor(ss, 16); ss += __shfl_xor(ss, 32);
                if (fq == 0) rowss[row * 16 + u.pn * 4 + wc] = ss;
            }
        }
#undef EO0_LOAD
    }
};

struct EpiIn1 {
    static constexpr bool PERM = true;
    const Params* P;
    __device__ __forceinline__ void operator()(acc_t& acc, const pg8::Unit& u, int wr, int wc, int fr, int fq, LAS unsigned char* lds) const {
        unsigned char* ws = P->ws;
        LAS float* xch = (LAS float*)(lds + EPI_LDS);
        LAS float* rsx = (LAS float*)(lds + EPI_LDS + 8192);
        if (threadIdx.x < 256) {
            const float* rowss = (const float*)(ws + WS_ROWSS) + ((size_t)u.pm * 256 + threadIdx.x) * 16;
            float s = 0.f;
#pragma unroll
            for (int i = 0; i < 16; ++i) s += rowss[i];
            rsx[threadIdx.x] = rsqrtf(s * (1.0f / 1024.0f) + 1e-6f);
        }
        EPI_BAR();
#pragma unroll
        for (int ai = 0; ai < 2; ++ai)
#pragma unroll
            for (int m = 0; m < 4; ++m) {
                const float rs = rsx[ai * 128 + wr * 64 + m * 16 + fr];
#pragma unroll
                for (int bj = 0; bj < 2; ++bj) { acc[ai][bj][m][0] *= rs; acc[ai][bj][m][1] *= rs; }
            }
        const bool anynorm = (u.pn <= 4);
        if (anynorm) {
#pragma unroll
            for (int bj = 0; bj < 2; ++bj)
#pragma unroll
                for (int ai = 0; ai < 2; ++ai)
#pragma unroll
                    for (int m = 0; m < 4; ++m) {
                        const float s = ss32(acc[ai][bj][m][0], acc[ai][bj][m][1]);
                        if (fq == 0) xch[((wr * 4 + wc) * 2 + bj) * 128 + ai * 64 + m * 16 + fr] = s;
                    }
            EPI_BAR();
        }
#pragma unroll
        for (int bj = 0; bj < 2; ++bj) {
            const int cb = u.pn * 256 + bj * 128;
            const int cl = wc * 32 + fq * 8;
            const int col0 = cb + cl;
#pragma unroll
            for (int ai = 0; ai < 2; ++ai)
#pragma unroll
                for (int m = 0; m < 4; ++m) {
                    const size_t row = (size_t)u.pm * 256 + ai * 128 + wr * 64 + m * 16 + fr;
                    f4 a = acc[ai][bj][m][0], b = acc[ai][bj][m][1];
                    if (cb < 1280) {
                        const int ri = ai * 64 + m * 16 + fr;
                        float tot = 0.f;
#pragma unroll
                        for (int c2 = 0; c2 < 4; ++c2) tot += xch[((wr * 4 + c2) * 2 + bj) * 128 + ri];
                        const float sc = rsqrtf(tot * (1.0f / 128.0f) + 1e-6f);
                        const float* gw = (cb < 1024) ? P->in[20] : P->in[21];
                        const f4 g0 = *(const f4*)(gw + cl), g1 = *(const f4*)(gw + cl + 4);
                        a = a * sc * g0; b = b * sc * g1;
                        const size_t kvrow = ((size_t)((row >> 13) * 2 + ((cb >> 7) & 1)) * SEQ + (row & 8191)) * 256;
                        unsigned char* dst = (cb < 1024) ? (ws + WS_RA + row * 1024 + col0) : (ws + WS_V1 + kvrow + cl);
                        *(unsigned long long*)dst = pack8_fp8(a, b);
                    } else if (cb < 1536) {
                        const size_t kvrow = ((size_t)((row >> 13) * 2 + ((cb >> 7) & 1)) * SEQ + (row & 8191)) * 256;
                        *(unsigned long long*)(ws + WS_V1 + kvrow + 128 + cl) = pack8_fp8(a, b);
                    } else if (cb < 2560) {
#pragma unroll
                        for (int e = 0; e < 4; ++e) { a[e] = silu_f(a[e]); b[e] = silu_f(b[e]); }
                        *(h8*)((hf*)(ws + WS_RB + 32 * MiB) + row * 1024 + (col0 - 1536)) = pack8(a, b);
                    } else if (cb < 3072) {
                        *(h8*)((hf*)(ws + WS_RC) + row * 512 + (col0 - 2560)) = pack8(a, b);
                    } else if (cb == 3072) {
                        if (cl < 64) *(h8*)((hf*)(ws + WS_KI) + row * 64 + cl) = pack8(a, b);
                        else if (cl == 64) { float* wi = (float*)(ws + WS_WI) + row * 8; *(f4*)wi = a * 0.04419417382415922f; *(f4*)(wi + 4) = b * 0.04419417382415922f; }
                    }
                }
        }
        EPI_BAR();
    }
};

struct EpiOut1 {
    static constexpr bool PERM = false;
    const Params* P;
    __device__ __forceinline__ void operator()(acc_t& acc, const pg8::Unit& u, int wr, int wc, int fr, int fq, LAS unsigned char* lds) const {
        float* out = P->out; const hf* h1 = (const hf*)(P->ws + WS_H1);
        const size_t row0 = (size_t)u.pm * 256 + wr * 64 + fr;
        const int colb = u.pn * 256 + wc * 32 + fq * 4;
        h4 hv[2][4][2][2];
#pragma unroll
        for (int ai = 0; ai < 2; ++ai)
#pragma unroll
            for (int m = 0; m < 4; ++m)
#pragma unroll
                for (int bj = 0; bj < 2; ++bj)
#pragma unroll
                    for (int n = 0; n < 2; ++n) hv[ai][m][bj][n] = *(const h4*)(h1 + (row0 + ai * 128 + m * 16) * DM + colb + bj * 128 + n * 16);
#pragma unroll
        for (int ai = 0; ai < 2; ++ai)
#pragma unroll
            for (int m = 0; m < 4; ++m)
#pragma unroll
                for (int bj = 0; bj < 2; ++bj)
#pragma unroll
                    for (int n = 0; n < 2; ++n) {
                        f4 o = acc[ai][bj][m][n];
                        const h4 v = hv[ai][m][bj][n];
                        o[0] += (float)v[0]; o[1] += (float)v[1]; o[2] += (float)v[2]; o[3] += (float)v[3];
                        *(f4*)(out + (row0 + ai * 128 + m * 16) * DM + colb + bj * 128 + n * 16) = o;
                    }
    }
};

__device__ __forceinline__ l2 lane_tr(const l2& v, int bpa) {
    typedef int i4v __attribute__((ext_vector_type(4)));
    i4v x = __builtin_bit_cast(i4v, v);
#pragma unroll
    for (int e = 0; e < 4; ++e) x[e] = __builtin_amdgcn_ds_bpermute(bpa, x[e]);
    return __builtin_bit_cast(l2, x);
}
__device__ __forceinline__ h8 lane_tr(const h8& v, int bpa) { return __builtin_bit_cast(h8, lane_tr(__builtin_bit_cast(l2, v), bpa)); }
constexpr int THIN_LD = 2064;
__device__ __forceinline__ void thin_load_a(const hf* A, int r0, char* smem) {
    for (int i = threadIdx.x; i < 8192; i += NTHR) { const int row = i >> 7, pc = i & 127; *(h8*)(smem + row * THIN_LD + pc * 16) = *(const h8*)(A + (size_t)(r0 + row) * 1024 + pc * 8); }
}
template <int NT>
__device__ __forceinline__ void thin_mma(const char* smem, const hf* Wt, int n0, f4 (&acc)[4][NT], int lane) {
    const int l15 = lane & 15, g4 = lane >> 4, bpa = 4 * (4 * l15 + g4);
    const hf* bp[NT];
#pragma unroll
    for (int t = 0; t < NT; ++t) bp[t] = Wt + (size_t)(n0 + t * 16 + (lane >> 2)) * 1024 + (lane & 3) * 8;
#pragma unroll
    for (int m = 0; m < 4; ++m)
#pragma unroll
        for (int t = 0; t < NT; ++t) acc[m][t] = (f4){0.f, 0.f, 0.f, 0.f};
    h8 bq[2][NT];
#pragma unroll
    for (int t = 0; t < NT; ++t) bq[0][t] = *(const h8*)bp[t];
    const char* ap = smem + l15 * THIN_LD + g4 * 16;
    for (int ks = 0; ks < 32; ks += 2) {
#pragma unroll
        for (int u = 0; u < 2; ++u) {
            const int k1 = ks + u + 1;
            if (k1 < 32) {
#pragma unroll
                for (int t = 0; t < NT; ++t) bq[(u + 1) & 1][t] = *(const h8*)(bp[t] + k1 * 32);
            }
            h8 bf[NT];
#pragma unroll
            for (int t = 0; t < NT; ++t) bf[t] = lane_tr(bq[u][t], bpa);
#pragma unroll
            for (int m = 0; m < 4; ++m) {
                const h8 af = *(const h8*)(ap + m * 16 * THIN_LD + (ks + u) * 64);
#pragma unroll
                for (int t = 0; t < NT; ++t) acc[m][t] = __builtin_amdgcn_mfma_f32_16x16x32_f16(af, bf[t], acc[m][t], 0, 0, 0);
            }
        }
    }
}
__device__ __forceinline__ void thin_kv(const Params& P, char* smem) {
    const int tid = threadIdx.x, lane = tid & 63, w = tid >> 6, l15 = lane & 15, g4 = lane >> 4;
    unsigned char* ws = P.ws;
    hf* z0 = (hf*)(ws + WS_RB);
    float* xch = (float*)(smem + 64 * THIN_LD);
    for (int panel = blockIdx.x; panel < 256; panel += gridDim.x) {
        thin_load_a((const hf*)(ws + WS_RA), panel * 64, smem);
        __syncthreads();
        f4 acc[4][2];
        thin_mma<2>(smem, (const hf*)(ws + WS_WT_IN0), 2048 + w * 32, acc, lane);
        float ssl[4][4];
        if (w < 4) {
#pragma unroll
            for (int m = 0; m < 4; ++m)
#pragma unroll
                for (int r = 0; r < 4; ++r) {
                    float ss = acc[m][0][r] * acc[m][0][r] + acc[m][1][r] * acc[m][1][r];
                    ss = red16(ss); ssl[m][r] = ss;
                    if (l15 == 0) xch[w * 64 + m * 16 + 4 * g4 + r] = ss;
                }
        }
        __syncthreads();
        float gk[2] = {1.f, 1.f};
        if (w < 4) { gk[0] = P.in[6][(w & 1) * 32 + l15]; gk[1] = P.in[6][(w & 1) * 32 + 16 + l15]; }
#pragma unroll
        for (int m = 0; m < 4; ++m)
#pragma unroll
            for (int r = 0; r < 4; ++r) {
                float sc = 1.f;
                if (w < 4) sc = rsqrtf((ssl[m][r] + xch[(w ^ 1) * 64 + m * 16 + 4 * g4 + r]) * (1.0f / 64.0f) + 1e-6f);
                const size_t row = (size_t)panel * 64 + m * 16 + 4 * g4 + r;
#pragma unroll
                for (int t = 0; t < 2; ++t) z0[row * N0 + 512 + w * 32 + t * 16 + l15] = (hf)(acc[m][t][r] * sc * gk[t]);
            }
        __syncthreads();
    }
}
__device__ __forceinline__ void thin_ki(const Params& P, char* smem) {
    const int tid = threadIdx.x, lane = tid & 63, w = tid >> 6, l15 = lane & 15, g4 = lane >> 4;
    unsigned char* ws = P.ws;
    float* rsx = (float*)(smem + 64 * THIN_LD);
    for (int panel = blockIdx.x; panel < 256; panel += gridDim.x) {
        thin_load_a((const hf*)(ws + WS_H1), panel * 64, smem);
        if (tid < 64) {
            const float* rowss = (const float*)(ws + WS_ROWSS) + ((size_t)panel * 64 + tid) * 16;
            float s = 0.f;
#pragma unroll
            for (int i = 0; i < 16; ++i) s += rowss[i];
            rsx[tid] = rsqrtf(s * (1.0f / 1024.0f) + 1e-6f);
        }
        __syncthreads();
        if (w < 5) {
            f4 acc[4][1];
            thin_mma<1>(smem, (const hf*)(ws + WS_WT_IN1), 3072 + w * 16, acc, lane);
#pragma unroll
            for (int m = 0; m < 4; ++m)
#pragma unroll
                for (int r = 0; r < 4; ++r) {
                    const int rl = m * 16 + 4 * g4 + r;
                    const size_t row = (size_t)panel * 64 + rl;
                    const float v = acc[m][0][r] * rsx[rl];
                    if (w < 4) ((hf*)(ws + WS_KI))[row * 64 + w * 16 + l15] = (hf)v;
                    else if (l15 < 8) ((float*)(ws + WS_WI))[row * 8 + l15] = v * 0.04419417382415922f;
                }
        }
        __syncthreads();
    }
}

__device__ __forceinline__ void swa_item(const Params& P, int item, char* smem) {
    const int tid = threadIdx.x, lane = tid & 63, w = tid >> 6, l15 = lane & 15, g4 = lane >> 4;
    unsigned char* ws = P.ws;
    const int kv = item & 1, n = (item >> 1) & 63, b = item >> 7;
    const hf* z0 = (const hf*)(ws + WS_RB);
    hf* cat = (hf*)(ws + WS_RA);
    hf* sK = (hf*)smem;
    hf* sV = (hf*)(smem + 32768);
    float* sBias = (float*)(smem + 32768 + 36864);
    constexpr int VST = 72;
    const int tok0 = b * SEQ + n * 128;
    for (int i = tid; i < 256 * 8; i += NTHR) {
        const int j = i >> 3, ch = i & 7;
        h8 v = (h8){0, 0, 0, 0, 0, 0, 0, 0};
        if (n > 0 || j >= 128) v = *(const h8*)(z0 + (size_t)(tok0 - 128 + j) * N0 + 512 + kv * 64 + ch * 8);
        *(h8*)(sK + j * 64 + ((ch ^ (j & 7)) * 8)) = v;
    }
    for (int i = tid; i < 256 * 8; i += NTHR) {
        const int j = i >> 3, ch = i & 7;
        h8 v = (h8){0, 0, 0, 0, 0, 0, 0, 0};
        if (n > 0 || j >= 128) v = *(const h8*)(z0 + (size_t)(tok0 - 128 + j) * N0 + 640 + kv * 64 + ch * 8);
        *(h8*)(sV + j * VST + ch * 8) = v;
    }
    {
        const float* b0 = (const float*)(ws + WS_TAB + TAB_BIAS0);
        sBias[tid] = b0[(kv * 4 + (tid >> 7)) * 128 + (tid & 127)];
    }
    __syncthreads();
    const int g = w >> 1, th = w & 1, h = kv * 4 + g;
    const float sink = P.in[7][h];
    for (int tt = 0; tt < 4; ++tt) {
        const int i0 = th * 64 + tt * 16;
        const int tokrow = tok0 + i0 + l15;
        h8 qf[2];
#pragma unroll
        for (int ks = 0; ks < 2; ++ks) qf[ks] = *(const h8*)(z0 + (size_t)tokrow * N0 + h * 64 + ks * 32 + g4 * 8);
        f4 s[9];
        const int jt0 = i0 >> 4;
#pragma unroll
        for (int c = 0; c < 9; ++c) {
            s[c] = (f4){0.f, 0.f, 0.f, 0.f};
            const int key = (jt0 + c) * 16 + l15;
#pragma unroll
            for (int ks = 0; ks < 2; ++ks) {
                const h8 kf = *(const h8*)(sK + key * 64 + (((ks * 4 + g4) ^ (key & 7)) * 8));
                s[c] = __builtin_amdgcn_mfma_f32_16x16x32_f16(kf, qf[ks], s[c], 0, 0, 0);
            }
        }
        const int i = i0 + l15;
        float m = sink;
#pragma unroll
        for (int c = 0; c < 9; ++c)
#pragma unroll
            for (int r = 0; r < 4; ++r) {
                const int j = (jt0 + c) * 16 + 4 * g4 + r;
                const int d = i + 128 - j;
                const bool valid = (d >= 0) && (d < 128) && (n > 0 || j >= 128);
                const float lg = valid ? (s[c][r] * 0.125f + sBias[g * 128 + (d & 127)]) : -1e30f;
                s[c][r] = lg; m = fmaxf(m, lg);
            }
        m = fmaxf(m, __shfl_xor(m, 16)); m = fmaxf(m, __shfl_xor(m, 32));
        float sum = 0.f;
#pragma unroll
        for (int c = 0; c < 9; ++c)
#pragma unroll
            for (int r = 0; r < 4; ++r) { const float p = (s[c][r] > -1e29f) ? __expf(s[c][r] - m) : 0.f; s[c][r] = p; sum += p; }
        sum += __shfl_xor(sum, 16); sum += __shfl_xor(sum, 32);
        sum += __expf(sink - m);
        const float inv = 1.0f / sum;
        f4 o[4];
#pragma unroll
        for (int mt = 0; mt < 4; ++mt) o[mt] = (f4){0.f, 0.f, 0.f, 0.f};
#pragma unroll
        for (int k2 = 0; k2 < 5; ++k2) {
            const int ca = 2 * k2, cb = 2 * k2 + 1;
            h8 pf;
#pragma unroll
            for (int r = 0; r < 4; ++r) { pf[r] = (hf)s[ca][r]; pf[4 + r] = (cb < 9) ? (hf)s[cb][r] : (hf)0; }
            const int q4 = l15 >> 2, p4 = l15 & 3;
#pragma unroll
            for (int mt = 0; mt < 4; ++mt) {
                const fp16x4_t lo = __builtin_amdgcn_ds_read_tr16_b64_v4f16((LAS fp16x4_t*)(sV + ((jt0 + ca) * 16 + 4 * g4 + q4) * VST + mt * 16 + 4 * p4));
                h4 va = __builtin_bit_cast(h4, lo), vb = (h4){0, 0, 0, 0};
                if (cb < 9) { const fp16x4_t hi = __builtin_amdgcn_ds_read_tr16_b64_v4f16((LAS fp16x4_t*)(sV + ((jt0 + cb) * 16 + 4 * g4 + q4) * VST + mt * 16 + 4 * p4)); vb = __builtin_bit_cast(h4, hi); }
                h8 vf; vf[0] = va[0]; vf[1] = va[1]; vf[2] = va[2]; vf[3] = va[3]; vf[4] = vb[0]; vf[5] = vb[1]; vf[6] = vb[2]; vf[7] = vb[3];
                o[mt] = __builtin_amdgcn_mfma_f32_16x16x32_f16(vf, pf, o[mt], 0, 0, 0);
            }
        }
#pragma unroll
        for (int mt = 0; mt < 4; ++mt) {
            const int dcol = h * 64 + mt * 16 + 4 * g4;
            const h4 sg = *(const h4*)(z0 + (size_t)tokrow * N0 + 768 + dcol);
            h4 ov;
#pragma unroll
            for (int r = 0; r < 4; ++r) ov[r] = (hf)(o[mt][r] * inv * (float)sg[r]);
            *(h4*)(cat + (size_t)tokrow * DM + dcol) = ov;
        }
    }
    __syncthreads();
}

template <int MODE>
__device__ __forceinline__ void ssm_item(const Params& P, int item, char* smem) {
    const int tid = threadIdx.x, lane = tid & 63, w = tid >> 6, l15 = lane & 15, g4 = lane >> 4;
    unsigned char* ws = P.ws;
    const int b = item >> 7, c = item & 127;
    const hf* z0 = (const hf*)(ws + WS_RB);
    float* S = (float*)(ws + WS_SC);
    hf* yg = (hf*)(ws + WS_RC);
    float* sBU = (float*)(smem + w * 14592);
    hf* sX = (hf*)(smem + w * 14592 + 10240);
    const float* tab_ab = (const float*)(ws + WS_TAB + TAB_AB);
    const float* tab_at = (const float*)(ws + WS_TAB + TAB_AT);
    const float* tab_dt = (const float*)(ws + WS_TAB + TAB_DT);
    const hf* bbs = (const hf*)(ws + WS_TAB + TAB_BBS);
    const hf* cri = (const hf*)(ws + WS_TAB + TAB_CRI);
    const int tokc = b * SEQ + c * 64;
    float cr[4], ci[4];
#pragma unroll
    for (int q = 0; q < 4; ++q) { cr[q] = 0.f; ci[q] = 0.f; }
    if (MODE == 1) {
        const float* Cb = (const float*)(ws + WS_CIN) + ((size_t)(b * 128 + c) * 32 + w * 4) * 128 + lane;
#pragma unroll
        for (int q = 0; q < 4; ++q) { cr[q] = Cb[q * 128]; ci[q] = Cb[q * 128 + 64]; }
    }
    for (int q = 0; q < 4; ++q) {
        const int g = w * 4 + q;
        const float abr = tab_ab[(g * 64 + lane) * 2], abi = tab_ab[(g * 64 + lane) * 2 + 1];
        h4 bf[8];
#pragma unroll
        for (int nt = 0; nt < 8; ++nt) bf[nt] = *(const h4*)(bbs + ((size_t)g * 128 + nt * 16 + l15) * 16 + 4 * g4);
        h8 cf[4];
        float dtg = 0.f, dsk = 0.f;
        if (MODE == 1) {
#pragma unroll
            for (int ks = 0; ks < 4; ++ks) cf[ks] = *(const h8*)(cri + ((size_t)g * 16 + l15) * 128 + ks * 32 + g4 * 8);
            dtg = tab_dt[g]; dsk = P.in[15][g * 16 + l15];
        }
        float xr = 0.f, xi = 0.f;
        if (MODE == 1) { xr = (q == 0) ? cr[0] : (q == 1) ? cr[1] : (q == 2) ? cr[2] : cr[3]; xi = (q == 0) ? ci[0] : (q == 1) ? ci[1] : (q == 2) ? ci[2] : ci[3]; }
        h4 ufn = *(const h4*)(z0 + (size_t)(tokc + l15) * N0 + 1280 + g * 16 + 4 * g4);
        hf uen[4];
#pragma unroll
        for (int r = 0; r < 4; ++r) uen[r] = (MODE == 1) ? z0[(size_t)(tokc + 4 * g4 + r) * N0 + 1280 + g * 16 + l15] : (hf)0;
#pragma unroll 1
        for (int mt = 0; mt < 4; ++mt) {
            const int tokm = tokc + mt * 16;
            const h4 uf = ufn;
            hf ue[4];
#pragma unroll
            for (int r = 0; r < 4; ++r) ue[r] = uen[r];
            if (mt + 1 < 4) {
                ufn = *(const h4*)(z0 + (size_t)(tokm + 16 + l15) * N0 + 1280 + g * 16 + 4 * g4);
                if (MODE == 1) {
#pragma unroll
                    for (int r = 0; r < 4; ++r) uen[r] = z0[(size_t)(tokm + 16 + 4 * g4 + r) * N0 + 1280 + g * 16 + l15];
                }
            }
#pragma unroll
            for (int nt = 0; nt < 8; ++nt) {
                f4 d = (f4){0.f, 0.f, 0.f, 0.f};
                d = __builtin_amdgcn_mfma_f32_16x16x16f16(uf, bf[nt], d, 0, 0, 0);
                *(f4*)(sBU + (nt * 16 + l15) * 20 + 4 * g4) = d;
            }
            LDS_FENCE();
            f4 bre[4], bim[4];
#pragma unroll
            for (int k = 0; k < 4; ++k) { bre[k] = *(const f4*)(sBU + lane * 20 + 4 * k); bim[k] = *(const f4*)(sBU + (64 + lane) * 20 + 4 * k); }
#pragma unroll
            for (int t = 0; t < 16; ++t) {
                const float bur = bre[t >> 2][t & 3], bui = bim[t >> 2][t & 3];
                const float nr = abr * xr - abi * xi + bur;
                const float ni = abr * xi + abi * xr + bui;
                xr = nr; xi = ni;
                if (MODE == 1) { h2 xv; xv[0] = (hf)xr; xv[1] = (hf)xi; *(h2*)(sX + t * 136 + 2 * lane) = xv; }
            }
            LDS_FENCE();
            if (MODE == 1) {
                f4 y = (f4){0.f, 0.f, 0.f, 0.f};
#pragma unroll
                for (int ks = 0; ks < 4; ++ks) {
                    const h8 xf = *(const h8*)(sX + l15 * 136 + ks * 32 + g4 * 8);
                    y = __builtin_amdgcn_mfma_f32_16x16x32_f16(xf, cf[ks], y, 0, 0, 0);
                }
#pragma unroll
                for (int r = 0; r < 4; ++r) {
                    const size_t row = tokm + 4 * g4 + r;
                    const float u = (float)ue[r];
                    const float yv = dtg * y[r] + dsk * u;
                    yg[row * 512 + g * 16 + l15] = (hf)gelu_tanh_f(yv);
                }
                LDS_FENCE();
            }
        }
        if (MODE == 0) {
            float* Sd = S + ((size_t)(b * 128 + c) * 32 + g) * 128;
            Sd[lane] = xr; Sd[64 + lane] = xi;
        }
    }
}

__device__ __forceinline__ void carry_scan(const Params& P, char* smem) {
    const int tid = threadIdx.x, lane = tid & 63, w = tid >> 6;
    unsigned char* ws = P.ws;
    const float* S = (const float*)(ws + WS_SC);
    float* Cin = (float*)(ws + WS_CIN);
    const float* tab_at = (const float*)(ws + WS_TAB + TAB_AT);
    float* sT = (float*)smem;
    for (int tp = blockIdx.x; tp < 32; tp += gridDim.x) {
        const int task = tp * 2 + (w >> 2), seg = w & 3;
        const int b = task >> 5, g = task & 31;
        const float atr = tab_at[(g * 64 + lane) * 2], ati = tab_at[(g * 64 + lane) * 2 + 1];
        const float* Sp = S + ((size_t)(b * 128 + seg * 32) * 32 + g) * 128 + lane;
        float* Cp = Cin + ((size_t)(b * 128 + seg * 32) * 32 + g) * 128 + lane;
        float sr[32], si[32];
#pragma unroll
        for (int i = 0; i < 32; ++i) { sr[i] = Sp[(size_t)i * 4096]; si[i] = Sp[(size_t)i * 4096 + 64]; }
        float xr = 0.f, xi = 0.f;
#pragma unroll
        for (int i = 0; i < 32; ++i) {
            const float nr = atr * xr - ati * xi + sr[i], ni = atr * xi + ati * xr + si[i];
            sr[i] = xr; si[i] = xi; xr = nr; xi = ni;
        }
        sT[((w >> 2) * 4 + seg) * 128 + lane] = xr; sT[((w >> 2) * 4 + seg) * 128 + 64 + lane] = xi;
        __syncthreads();
        float pr = atr, pi = ati;
#pragma unroll
        for (int i = 0; i < 5; ++i) { const float nr = pr * pr - pi * pi, ni = 2.f * pr * pi; pr = nr; pi = ni; }
        float Xr = 0.f, Xi = 0.f;
        for (int k = 0; k < seg; ++k) {
            const float tr = sT[((w >> 2) * 4 + k) * 128 + lane], ti = sT[((w >> 2) * 4 + k) * 128 + 64 + lane];
            const float nr = pr * Xr - pi * Xi + tr, ni = pr * Xi + pi * Xr + ti;
            Xr = nr; Xi = ni;
        }
        float qr = 1.f, qi = 0.f;
#pragma unroll
        for (int i = 0; i < 32; ++i) {
            Cp[(size_t)i * 4096] = sr[i] + qr * Xr - qi * Xi;
            Cp[(size_t)i * 4096 + 64] = si[i] + qr * Xi + qi * Xr;
            const float nr = qr * atr - qi * ati, ni = qr * ati + qi * atr; qr = nr; qi = ni;
        }
        __syncthreads();
    }
}

constexpr int CAND_CAP = 128;

__device__ __forceinline__ void idx_scores(const h8 (&qf)[8][2], const h8 (&ql)[2], const float (&wv)[8], const h8& k0, const h8& k1, float (&sc)[4]) {
    f4 lin = (f4){0.f, 0.f, 0.f, 0.f};
    lin = __builtin_amdgcn_mfma_f32_16x16x32_f16(k0, ql[0], lin, 0, 0, 0);
    lin = __builtin_amdgcn_mfma_f32_16x16x32_f16(k1, ql[1], lin, 0, 0, 0);
    sc[0] = lin[0]; sc[1] = lin[1]; sc[2] = lin[2]; sc[3] = lin[3];
#pragma unroll
    for (int h = 0; h < 8; ++h) {
        f4 a = (f4){0.f, 0.f, 0.f, 0.f};
        a = __builtin_amdgcn_mfma_f32_16x16x32_f16(k0, qf[h][0], a, 0, 0, 0);
        a = __builtin_amdgcn_mfma_f32_16x16x32_f16(k1, qf[h][1], a, 0, 0, 0);
#pragma unroll
        for (int r = 0; r < 4; ++r) sc[r] = __builtin_fmaf(wv[h], __builtin_fabsf(a[r]), sc[r]);
    }
}
__device__ __forceinline__ float score_t(float s2, float qs) { return __builtin_fmaf(s2, qs, 512.0f); }
__device__ __forceinline__ int t_bin(float t) { int bi = (int)t; bi = bi < 0 ? 0 : (bi > 1023 ? 1023 : bi); return bi; }

constexpr int SEG_CAP = 144;
__device__ __forceinline__ void find_bin(const u32* h, int T, int lane, int& bsel, int& nabove) {
    u32 wd[16]; int tot = 0;
#pragma unroll
    for (int i = 0; i < 4; ++i) { const uint4 v = *(const uint4*)(h + 1008 - 16 * lane + 4 * i); wd[4 * i] = v.x; wd[4 * i + 1] = v.y; wd[4 * i + 2] = v.z; wd[4 * i + 3] = v.w; tot += (int)(v.x + v.y + v.z + v.w); }
    int pre = tot;
    pre += __builtin_amdgcn_update_dpp(0, pre, 0x111, 0xf, 0xf, true); pre += __builtin_amdgcn_update_dpp(0, pre, 0x112, 0xf, 0xf, true);
    pre += __builtin_amdgcn_update_dpp(0, pre, 0x114, 0xf, 0xf, true); pre += __builtin_amdgcn_update_dpp(0, pre, 0x118, 0xf, 0xf, true);
    pre += __builtin_amdgcn_update_dpp(0, pre, 0x142, 0xa, 0xf, false);
    pre += __builtin_amdgcn_update_dpp(0, pre, 0x143, 0xc, 0xf, false);
    const int excl = pre - tot;
    const bool mine = (excl < T) && (pre >= T);
    int found = -1, fab = 0;
    if (mine) {
        int cum = excl;
#pragma unroll
        for (int i = 15; i >= 0; --i) {
            const int cntb = (int)wd[i];
            if (found < 0 && cum + cntb >= T) { found = 1008 - 16 * lane + i; fab = cum; }
            cum += cntb;
        }
    }
    const unsigned long long bm = __ballot(mine);
    if (bm) { const int srcl = __ffsll((long long)bm) - 1; bsel = __shfl(found, srcl); nabove = __shfl(fab, srcl); }
    else { bsel = -1; nabove = __shfl(pre, 63); }
}
__device__ __forceinline__ void select_load_q(const Params& P, int b, int n16, h8 (&qf)[8][2], float (&wv)[8]) {
    const int lane = threadIdx.x & 63, l15 = lane & 15, g4 = lane >> 4;
    const hf* qi = (const hf*)(P.ws + WS_RC);
    const float* wi = (const float*)(P.ws + WS_WI);
    const size_t qrow = (size_t)b * SEQ + n16 * 16 + l15;
#pragma unroll
    for (int h = 0; h < 8; ++h) {
        qf[h][0] = *(const h8*)(qi + qrow * 512 + h * 64 + g4 * 8);
        qf[h][1] = *(const h8*)(qi + qrow * 512 + h * 64 + 32 + g4 * 8);
        wv[h] = wi[qrow * 8 + h];
    }
}
__device__ __forceinline__ void select_item(const Params& P, int b, int n16, bool has_next, int n16_next, char* smem, h8 (&qf)[8][2], float (&wv)[8]) {
    const int tid = threadIdx.x, lane = tid & 63, w = tid >> 6, l15 = lane & 15, g4 = lane >> 4;
    unsigned char* ws = P.ws;
    const hf* qi = (const hf*)(ws + WS_RC);
    const hf* kib = (const hf*)(ws + WS_KI) + (size_t)b * SEQ * 64;
    const float* wi = (const float*)(ws + WS_WI);
    u16* lists = (u16*)(ws + WS_LIST);
    int* cnts = (int*)(ws + WS_CNT);
    u32* hist = (u32*)smem;
    const int t0 = n16 * 16;
    const int ksplit = w;
    const int tq = t0 + l15;
    const int ql = l15;
    float qscale;
    {
        float w2 = 0.f;
#pragma unroll
        for (int h = 0; h < 8; ++h) w2 = __builtin_fmaf(wv[h], wv[h], w2);
        qscale = 8.0f / fmaxf(sqrtf(w2), 1e-6f);
    }
    float* qsc = (float*)(smem + 143360 + 768);
    if (ksplit == 0 && g4 == 0) qsc[ql] = qscale;
    h8 qlin[2];
    {
        float sl[2][8];
#pragma unroll
        for (int k = 0; k < 2; ++k)
#pragma unroll
            for (int e = 0; e < 8; ++e) sl[k][e] = 0.f;
#pragma unroll
        for (int h = 0; h < 8; ++h) {
#pragma unroll
            for (int k = 0; k < 2; ++k)
#pragma unroll
                for (int e = 0; e < 8; ++e) sl[k][e] = __builtin_fmaf(wv[h], (float)qf[h][k][e], sl[k][e]);
            __builtin_amdgcn_sched_barrier(0);
        }
#pragma unroll
        for (int k = 0; k < 2; ++k)
#pragma unroll
            for (int e = 0; e < 8; ++e) qlin[k][e] = (hf)sl[k][e];
    }
    const int ktd = t0 >> 4;
    const int nmine = (ktd - ksplit + 8) >> 3;
    const unsigned koff = (unsigned)(l15 * 128 + g4 * 16);
    h8 ka[3][2];
#define KI_ISSUE(slot, j) do { int kt_ = ksplit + 8 * (j); kt_ = kt_ > ktd ? ktd : kt_; const unsigned o_ = koff + (unsigned)kt_ * 2048u; ka[slot][0] = *(const h8*)((const char*)kib + o_); ka[slot][1] = *(const h8*)((const char*)kib + o_ + 64u); } while (0)
    float* seg_s = (float*)smem;
    u16* seg_i = (u16*)(smem + 73728);
    u32* whist = (u32*)(smem + 110592) + w * 1024;
    int* blo = (int*)(smem + 143360);
    int* segcnt = (int*)(smem + 143360 + 128);
    int* okflag = (int*)(smem + 143360 + 640);
    for (int attempt = (t0 + 16 <= 1024) ? 1 : 0; attempt < 2; ++attempt) {
        const int step = attempt == 0 ? 8 : 1;
        for (int i = tid; i < 4096; i += NTHR) ((uint4*)hist)[i] = make_uint4(0u, 0u, 0u, 0u);
        if (tid == 0) *okflag = 1;
        __syncthreads();
        if (nmine > 0) KI_ISSUE(0, 0);
        for (int j0 = 0; j0 < nmine; j0 += 2 * step) {
#pragma unroll
            for (int u = 0; u < 2; ++u) {
                const int j = j0 + u * step;
                KI_ISSUE((u + 1) & 1, j + step);
                __builtin_amdgcn_sched_barrier(0);
                if (j < nmine) {
                    const int kt = ksplit + 8 * j;
                    float sc[4];
                    idx_scores(qf, qlin, wv, ka[u][0], ka[u][1], sc);
                    if (kt < ktd) {
#pragma unroll
                        for (int r = 0; r < 4; ++r) atomicAdd(&hist[ql * 1024 + t_bin(score_t(sc[r], qscale))], 1u);
                    } else {
#pragma unroll
                        for (int r = 0; r < 4; ++r) { const int key = kt * 16 + 4 * g4 + r; if (key <= tq) atomicAdd(&hist[ql * 1024 + t_bin(score_t(sc[r], qscale))], 1u); }
                    }
                }
                __builtin_amdgcn_sched_barrier(0);
            }
        }
        __syncthreads();
        for (int qq = 0; qq < 2; ++qq) {
            const int q = w * 2 + qq, nq = t0 + q + 1;
            int ns = 0;
            {
                const u32* hq = hist + q * 1024 + lane * 16;
#pragma unroll
                for (int i = 0; i < 4; ++i) { const uint4 v = *(const uint4*)(hq + 4 * i); ns += (int)(v.x + v.y + v.z + v.w); }
                ns += __builtin_amdgcn_update_dpp(0, ns, 0x111, 0xf, 0xf, true); ns += __builtin_amdgcn_update_dpp(0, ns, 0x112, 0xf, 0xf, true);
                ns += __builtin_amdgcn_update_dpp(0, ns, 0x114, 0xf, 0xf, true); ns += __builtin_amdgcn_update_dpp(0, ns, 0x118, 0xf, 0xf, true);
                ns += __builtin_amdgcn_update_dpp(0, ns, 0x142, 0xa, 0xf, false); ns += __builtin_amdgcn_update_dpp(0, ns, 0x143, 0xc, 0xf, false);
                ns = __builtin_amdgcn_readlane(ns, 63);
            }
            int T;
            if (attempt == 1) T = nq < 256 ? nq : 256;
            else { const float base = 256.0f * (float)ns / (float)nq; T = (int)(base + 4.5f * sqrtf(base) + 3.0f); }
            int bsel, nabove;
            find_bin(hist + q * 1024, T, lane, bsel, nabove);
            if (lane == 0) blo[q] = bsel < 0 ? 0 : bsel;
        }
        __syncthreads();
        int mycnt = 0;
        {
            const int bl = blo[ql];
            const float thr = (bl <= 0) ? -3.0e38f : ((float)bl - 512.0f) / qscale;
            float* mys = seg_s + (ql * 8 + ksplit) * SEG_CAP;
            u16* myi = seg_i + (ql * 8 + ksplit) * SEG_CAP;
            const unsigned long long colmask = 0x0001000100010001ULL << l15;
            if (nmine > 0) { KI_ISSUE(0, 0); KI_ISSUE(1, 1); }
            for (int j0 = 0; j0 < nmine; j0 += 3) {
#pragma unroll
                for (int u = 0; u < 3; ++u) {
                    const int j = j0 + u;
                    KI_ISSUE((u + 2) % 3, j + 2);
                    __builtin_amdgcn_sched_barrier(0);
                    if (j < nmine) {
                        const int kt = ksplit + 8 * j;
                        float sc[4];
                        idx_scores(qf, qlin, wv, ka[u][0], ka[u][1], sc);
#define SEL_ROW(SELEXPR) do { const bool sel = (SELEXPR); const unsigned long long bm = __ballot(sel) & colmask; \
                            const int pos = mycnt + (int)__builtin_amdgcn_mbcnt_hi((unsigned)(bm >> 32), __builtin_amdgcn_mbcnt_lo((unsigned)bm, 0u)); \
                            if (sel && pos < SEG_CAP) { mys[pos] = sc[r]; myi[pos] = (u16)(kt * 16 + 4 * g4 + r); } \
                            mycnt += __popcll(bm); } while (0)
                        if (kt < ktd) {
#pragma unroll
                            for (int r = 0; r < 4; ++r) SEL_ROW(sc[r] >= thr);
                        } else {
#pragma unroll
                            for (int r = 0; r < 4; ++r) SEL_ROW((kt * 16 + 4 * g4 + r <= tq) && (sc[r] >= thr));
                        }
#undef SEL_ROW
                    }
                    __builtin_amdgcn_sched_barrier(0);
                }
            }
            if (g4 == 0) segcnt[ql * 8 + ksplit] = mycnt < SEG_CAP ? mycnt : SEG_CAP;
            if (mycnt > SEG_CAP) *okflag = 0;
        }
        __syncthreads();
        if (tid < 16) { const int nq = t0 + tid + 1; int c = 0;
#pragma unroll
            for (int s = 0; s < 8; ++s) c += segcnt[tid * 8 + s];
            if (c < (nq < 256 ? nq : 256)) *okflag = 0; }
        __syncthreads();
        const int ok = *okflag;
        __syncthreads();
        if (ok) break;
    }
#undef KI_ISSUE
    if (has_next) select_load_q(P, b, n16_next, qf, wv);
    for (int qq = 0; qq < 2; ++qq) {
        const int q = w * 2 + qq, t = t0 + q, nq = t + 1;
        const float qs_q = qsc[q];
        int cs[8];
#pragma unroll
        for (int s = 0; s < 8; ++s) cs[s] = __builtin_amdgcn_readfirstlane(segcnt[q * 8 + s]);
#pragma unroll
        for (int i = 0; i < 4; ++i) *(uint4*)(whist + lane * 16 + 4 * i) = make_uint4(0u, 0u, 0u, 0u);
        WAVE_ORDER();
        float sv[8]; int kv_[8];
#pragma unroll
        for (int s = 0; s < 8; ++s) {
            const bool act = lane < cs[s];
            sv[s] = act ? seg_s[(q * 8 + s) * SEG_CAP + lane] : 0.f; kv_[s] = act ? (int)seg_i[(q * 8 + s) * SEG_CAP + lane] : 0;
        }
#pragma unroll
        for (int s = 0; s < 8; ++s) if (lane < cs[s]) atomicAdd(&whist[t_bin(score_t(sv[s], qs_q))], 1u);
#pragma unroll
        for (int s = 0; s < 8; ++s)
            for (int i = lane + 64; i < cs[s]; i += 64) atomicAdd(&whist[t_bin(score_t(seg_s[(q * 8 + s) * SEG_CAP + i], qs_q))], 1u);
        WAVE_ORDER();
        const int T = nq < 256 ? nq : 256;
        int bstar, nabove;
        find_bin(whist, T, lane, bstar, nabove);
        const int nd = T - nabove;
        WAVE_ORDER();
        u16* lp = lists + ((size_t)b * SEQ + t) * 256;
        float* tie_s = (float*)whist; int* tie_i = (int*)whist + 128;
        int base = 0, ntie = 0;
#define EMIT_CHUNK(ACT, SCV, KEY) do { const bool act = (ACT); const float scv = (SCV); const int key = (KEY); \
                const int bi = t_bin(score_t(scv, qs_q)); \
                const bool sel = act && bi > bstar, tie = act && bi == bstar; \
                const unsigned long long bm = __ballot(sel), bt = __ballot(tie); \
                const int pos = base + (int)__builtin_amdgcn_mbcnt_hi((unsigned)(bm >> 32), __builtin_amdgcn_mbcnt_lo((unsigned)bm, 0u)); \
                const int tp = ntie + (int)__builtin_amdgcn_mbcnt_hi((unsigned)(bt >> 32), __builtin_amdgcn_mbcnt_lo((unsigned)bt, 0u)); \
                if (sel && pos < 256) lp[pos] = (u16)key; \
                if (tie && tp < CAND_CAP) { tie_s[tp] = scv; tie_i[tp] = key; } \
                base += __popcll(bm); ntie += __popcll(bt); } while (0)
#pragma unroll
        for (int s = 0; s < 8; ++s) EMIT_CHUNK(lane < cs[s], sv[s], kv_[s]);
#pragma unroll
        for (int s = 0; s < 8; ++s)
            for (int i0 = 64; i0 < cs[s]; i0 += 64) {
                const int i = i0 + lane; const bool act = i < cs[s];
                const float scv = act ? seg_s[(q * 8 + s) * SEG_CAP + i] : 0.f; const int key = act ? (int)seg_i[(q * 8 + s) * SEG_CAP + i] : 0;
                const int bi = t_bin(score_t(scv, qs_q));
                const bool sel = act && bi > bstar, tie = act && bi == bstar;
                const unsigned long long bm = __ballot(sel), bt = __ballot(tie);
                const int pos = base + (int)__builtin_amdgcn_mbcnt_hi((unsigned)(bm >> 32), __builtin_amdgcn_mbcnt_lo((unsigned)bm, 0u));
                const int tp = ntie + (int)__builtin_amdgcn_mbcnt_hi((unsigned)(bt >> 32), __builtin_amdgcn_mbcnt_lo((unsigned)bt, 0u));
                if (sel && pos < 256) lp[pos] = (u16)key;
                if (tie && tp < CAND_CAP) { tie_s[tp] = scv; tie_i[tp] = key; }
                base += __popcll(bm); ntie += __popcll(bt);
            }
        WAVE_ORDER();
        const int nc = ntie < CAND_CAP ? ntie : CAND_CAP;
        if (nc > 0 && nd > 0) {
            const float s0 = (lane < nc) ? tie_s[lane] : -3.0e38f; const int i0 = (lane < nc) ? tie_i[lane] : 0x7fffffff;
            const float s1 = (lane + 64 < nc) ? tie_s[64 + lane] : -3.0e38f; const int i1 = (lane + 64 < nc) ? tie_i[64 + lane] : 0x7fffffff;
            int r0 = 0, r1 = 0;
            const int n0 = nc < 64 ? nc : 64;
            for (int j = 0; j < n0; ++j) {
                const float sj = __builtin_bit_cast(float, __builtin_amdgcn_readlane(__builtin_bit_cast(int, s0), j)); const int ij = __builtin_amdgcn_readlane(i0, j);
                r0 += (sj > s0 || (sj == s0 && ij < i0)) ? 1 : 0; r1 += (sj > s1 || (sj == s1 && ij < i1)) ? 1 : 0;
            }
            for (int j = 64; j < nc; ++j) {
                const float sj = __builtin_bit_cast(float, __builtin_amdgcn_readlane(__builtin_bit_cast(int, s1), j - 64)); const int ij = __builtin_amdgcn_readlane(i1, j - 64);
                r0 += (sj > s0 || (sj == s0 && ij < i0)) ? 1 : 0; r1 += (sj > s1 || (sj == s1 && ij < i1)) ? 1 : 0;
            }
            if (lane < nc && r0 < nd && base + r0 < 256) lp[base + r0] = (u16)i0;
            if (lane + 64 < nc && r1 < nd && base + r1 < 256) lp[base + r1] = (u16)i1;
        }
        if (lane == 0) { const int tot = base + (nd < nc ? nd : nc); cnts[(size_t)b * SEQ + t] = tot < 256 ? tot : 256; }
        WAVE_ORDER();
    }
    __syncthreads();
}

__device__ __forceinline__ void dsa_attn_phase(const Params& P, char* smem) {
    const int tid = threadIdx.x, lane = tid & 63, w = tid >> 6, l15 = lane & 15, g4 = lane >> 4;
    unsigned char* ws = P.ws;
    const unsigned char* q8 = ws + WS_RA;
    const unsigned char* k8 = ws + WS_RB + 64 * MiB;
    const unsigned char* v8 = ws + WS_V1;
    const hf* sg1 = (const hf*)(ws + WS_RB + 32 * MiB);
    hf* att = (hf*)(ws + WS_RB);
    const u16* lists = (const u16*)(ws + WS_LIST);
    const int* cnts = (const int*)(ws + WS_CNT);
    unsigned char* sBkt = (unsigned char*)smem;
    float* sRb = (float*)(smem + 8192);
    u16* sL = (u16*)(smem + 9216 + w * 512);
    float* sBT = (float*)(smem + 9216 + 8192 + w * 4096);
    unsigned char* sVw = (unsigned char*)smem + 50176 + w * 4608;
    unsigned char* sKw = (unsigned char*)smem + 87040 + w * 4608;
    const int kw_off = (lane >> 3) * 144 + (lane & 7) * 16, kr_off = l15 * 144 + g4 * 16;
    for (int i = tid; i < 2048; i += NTHR) ((u32*)sBkt)[i] = ((const u32*)(ws + WS_TAB + TAB_BKT))[i];
    if (tid < 256) sRb[tid] = P.in[1][tid];
    __syncthreads();
    const int n = l15;
    const int bpa = 4 * (4 * l15 + g4);
    long sel[2];
    {
        unsigned long long s0 = 0ull, s1 = 0ull;
#pragma unroll
        for (int j = 0; j < 8; ++j) { if (8 * g4 + j == l15) s0 |= 0x38ull << (8 * j); if (8 * g4 + j == 16 + l15) s1 |= 0x38ull << (8 * j); }
        sel[0] = (long)s0; sel[1] = (long)s1;
    }
    unsigned* qctr = (unsigned*)(ws + WS_BAR) + 3584;
    const int xg0 = (int)(xb_xcc_id() & 7u);
    u16* sLb[2] = {sL, sL + 2048};
    for (int gi = 0; gi < 8; ++gi) {
    const int xg = (xg0 + gi) & 7;
    const int b = xg >> 2, kv = (xg >> 1) & 1, half = xg & 1;
    const int h = kv * 4 + (n & 3);
    const unsigned char* kvg = v8 + (size_t)(b * 2 + kv) * SEQ * 256;
    const unsigned koff8 = (unsigned)((lane & 7) * 16);
    const unsigned char* kbase = kvg + koff8;
    const unsigned char* vbase = kbase + 128;
    int icur = 0;
    if (lane == 0) icur = (int)__hip_atomic_fetch_add(qctr + 64 * xg, 1u, __ATOMIC_RELAXED, __HIP_MEMORY_SCOPE_AGENT);
    icur = __builtin_amdgcn_readfirstlane(icur);
    int cnt = 0, buf = 0;
    if (icur < 4096) {
        const size_t row0 = (size_t)b * SEQ + 2 * icur + half;
        cnt = cnts[row0];
        const unsigned long long lv = *(const unsigned long long*)(lists + row0 * 256 + lane * 4);
#pragma unroll
        for (int j = 0; j < 4; ++j) sLb[0][lane * 4 + j] = (lane * 4 + j < cnt) ? (u16)(lv >> (16 * j)) : (u16)0;
    }
    LDS_FENCE();
    l2 kb[7][2]; l2 qa = (l2){0, 0}, qb = (l2){0, 0};
#define K_ISSUE_L(L, slot, c) do { const int ia_ = (L)[(c) * 16 + (lane >> 3)], ib_ = (L)[(c) * 16 + 8 + (lane >> 3)]; \
            kb[slot][0] = *(const l2*)(kvg + (koff8 + ((unsigned)ia_ << 8))); kb[slot][1] = *(const l2*)(kvg + (koff8 + ((unsigned)ib_ << 8))); } while (0)
    if (icur < 4096) {
        K_ISSUE_L(sLb[0], 0, 0); K_ISSUE_L(sLb[0], 1, 1);
        { const unsigned char* qp = q8 + ((size_t)b * SEQ + 2 * icur + half) * 1024 + h * 128 + g4 * 16; qa = *(const l2*)qp; qb = *(const l2*)(qp + 64); }
    }
    while (icur < 4096) {
        const u16* sLc = buf ? sLb[1] : sLb[0];
        u16* sLn = buf ? sLb[0] : sLb[1];
        const int t = 2 * icur + half;
        const size_t row = (size_t)b * SEQ + t;
        int inxt = 0;
        if (lane == 0) inxt = (int)__hip_atomic_fetch_add(qctr + 64 * xg, 1u, __ATOMIC_RELAXED, __HIP_MEMORY_SCOPE_AGENT);
        f4 s[4];
        long qm[4][4];
#pragma unroll
        for (int j = 0; j < 4; ++j) {
            const bool mine = (n >> 2) == j;
            qm[j][0] = mine ? qa[0] : 0L; qm[j][1] = mine ? qa[1] : 0L; qm[j][2] = mine ? qb[0] : 0L; qm[j][3] = mine ? qb[1] : 0L;
        }
#define K_ISSUE(slot, c) K_ISSUE_L(sLc, slot, c)
        K_ISSUE(2, 2); K_ISSUE(3, 3); K_ISSUE(4, 4); K_ISSUE(5, 5);
        __builtin_amdgcn_sched_barrier(0);
        {
            const u16* lq = sLc + lane * 4;
            int bk[4];
#pragma unroll
            for (int j = 0; j < 4; ++j) bk[j] = sBkt[t - (int)lq[j]];
            f4 bv[4];
#pragma unroll
            for (int j = 0; j < 4; ++j) bv[j] = *(const f4*)(sRb + bk[j] * 8 + kv * 4) * 1.4426950408889634f;
#pragma unroll
            for (int hh = 0; hh < 4; ++hh) *(f4*)(sBT + hh * 256 + lane * 4) = (f4){bv[0][hh], bv[1][hh], bv[2][hh], bv[3][hh]};
        }
        LDS_FENCE();
        __builtin_amdgcn_sched_barrier(0);
#pragma unroll
        for (int c2 = 0; c2 < 8; ++c2) {
            const int c = 2 * c2;
            if (c + 6 < 16) K_ISSUE((c + 6) % 7, c + 6);
            __builtin_amdgcn_sched_barrier(0);
            *(l2*)(sKw + kw_off) = kb[c % 7][0]; *(l2*)(sKw + kw_off + 8 * 144) = kb[c % 7][1];
            *(l2*)(sKw + 2304 + kw_off) = kb[(c + 1) % 7][0]; *(l2*)(sKw + 2304 + kw_off + 8 * 144) = kb[(c + 1) % 7][1];
            LDS_FENCE();
            if (c + 7 < 16) K_ISSUE((c + 7) % 7, c + 7);
            const l2 ka0 = *(const l2*)(sKw + kr_off), kb0 = *(const l2*)(sKw + kr_off + 64);
            const l2 ka1 = *(const l2*)(sKw + 2304 + kr_off), kb1 = *(const l2*)(sKw + 2304 + kr_off + 64);
            LDS_FENCE();
            f4 a = (c & 3) ? s[c >> 2] : (f4){0.f, 0.f, 0.f, 0.f};
            a = __builtin_amdgcn_mfma_f32_16x16x32_fp8_fp8(ka0[0], qm[c & 3][0], a, 0, 0, 0);
            a = __builtin_amdgcn_mfma_f32_16x16x32_fp8_fp8(ka0[1], qm[c & 3][1], a, 0, 0, 0);
            a = __builtin_amdgcn_mfma_f32_16x16x32_fp8_fp8(kb0[0], qm[c & 3][2], a, 0, 0, 0);
            a = __builtin_amdgcn_mfma_f32_16x16x32_fp8_fp8(kb0[1], qm[c & 3][3], a, 0, 0, 0);
            a = __builtin_amdgcn_mfma_f32_16x16x32_fp8_fp8(ka1[0], qm[(c & 3) + 1][0], a, 0, 0, 0);
            a = __builtin_amdgcn_mfma_f32_16x16x32_fp8_fp8(ka1[1], qm[(c & 3) + 1][1], a, 0, 0, 0);
            a = __builtin_amdgcn_mfma_f32_16x16x32_fp8_fp8(kb1[0], qm[(c & 3) + 1][2], a, 0, 0, 0);
            a = __builtin_amdgcn_mfma_f32_16x16x32_fp8_fp8(kb1[1], qm[(c & 3) + 1][3], a, 0, 0, 0);
            s[c >> 2] = a;
            __builtin_amdgcn_sched_barrier(0);
        }
#undef K_ISSUE
        l2 vb[3][2][2];
#define V_ISSUE(slot, k2) do { _Pragma("unroll") for (int tl = 0; tl < 2; ++tl) { const int ia_ = sLc[(k2) * 32 + tl * 16 + (lane >> 3)], ib_ = sLc[(k2) * 32 + tl * 16 + 8 + (lane >> 3)]; \
            vb[slot][tl][0] = *(const l2*)(kvg + (koff8 + 128u + ((unsigned)ia_ << 8))); vb[slot][tl][1] = *(const l2*)(kvg + (koff8 + 128u + ((unsigned)ib_ << 8))); } } while (0)
        V_ISSUE(0, 0); V_ISSUE(1, 1);
        inxt = __builtin_amdgcn_readfirstlane(inxt);
        int ncnt = 0; unsigned long long nlv = 0ull;
        if (inxt < 4096) { const size_t rown = (size_t)b * SEQ + 2 * inxt + half; ncnt = cnts[rown]; nlv = *(const unsigned long long*)(lists + rown * 256 + lane * 4); }
        __builtin_amdgcn_sched_barrier(0);
        const int myj = n >> 2;
        if (cnt != 256) {
#pragma unroll
            for (int ci = 0; ci < 4; ++ci)
#pragma unroll
                for (int r = 0; r < 4; ++r) s[ci][r] = ((4 * ci + myj) * 16 + 4 * g4 + r < cnt) ? s[ci][r] : -3.0e38f;
        }
        float m = -3.0e38f;
#pragma unroll
        for (int ci = 0; ci < 4; ++ci) {
            const f4 bb = *(const f4*)(sBT + (n & 3) * 256 + (4 * ci + myj) * 16 + 4 * g4);
#pragma unroll
            for (int r = 0; r < 4; ++r) { const float v = __builtin_fmaf(s[ci][r], 0.12751743074602467f, bb[r]); s[ci][r] = v; m = fmaxf(m, v); }
        }
        m = fmaxf(m, __builtin_bit_cast(float, __builtin_amdgcn_update_dpp(0, __builtin_bit_cast(int, m), 0x124, 0xf, 0xf, false)));
        m = fmaxf(m, __builtin_bit_cast(float, __builtin_amdgcn_update_dpp(0, __builtin_bit_cast(int, m), 0x128, 0xf, 0xf, false)));
        m = fmaxf(m, __shfl_xor(m, 16)); m = fmaxf(m, __shfl_xor(m, 32));
        float sum = 0.f;
        int p4[4];
#pragma unroll
        for (int ci = 0; ci < 4; ++ci) {
            float p[4];
#pragma unroll
            for (int r = 0; r < 4; ++r) { p[r] = __builtin_amdgcn_exp2f(s[ci][r] - m); sum += p[r]; }
            int lo = __builtin_amdgcn_cvt_pk_fp8_f32(p[0], p[1], 0, false); lo = __builtin_amdgcn_cvt_pk_fp8_f32(p[2], p[3], lo, true);
            p4[ci] = lo;
        }
        sum += __builtin_bit_cast(float, __builtin_amdgcn_update_dpp(0, __builtin_bit_cast(int, sum), 0x124, 0xf, 0xf, false));
        sum += __builtin_bit_cast(float, __builtin_amdgcn_update_dpp(0, __builtin_bit_cast(int, sum), 0x128, 0xf, 0xf, false));
        sum += __shfl_xor(sum, 16); sum += __shfl_xor(sum, 32);
        long pq[8];
#pragma unroll
        for (int k2 = 0; k2 < 8; ++k2) {
            const int src_ = p4[k2 >> 1];
            const int lo = (k2 & 1) ? __builtin_amdgcn_update_dpp(0, src_, 0x108, 0xf, 0xf, true) : src_;
            const int hi = (k2 & 1) ? __builtin_amdgcn_update_dpp(0, src_, 0x10C, 0xf, 0xf, true) : __builtin_amdgcn_update_dpp(0, src_, 0x104, 0xf, 0xf, true);
            pq[k2] = (long)(((unsigned long long)(unsigned)hi << 32) | (unsigned)lo);
        }
        const float inv = 1.0f / sum;
        f4 o[8];
#pragma unroll
        for (int mt = 0; mt < 8; ++mt) o[mt] = (f4){0.f, 0.f, 0.f, 0.f};
        __builtin_amdgcn_sched_barrier(0);
        V_ISSUE(2, 2);
        h4 sgv[8];
#pragma unroll
        for (int db = 0; db < 8; ++db) sgv[db] = *(const h4*)(sg1 + row * 1024 + h * 128 + db * 16 + 4 * g4);
        __builtin_amdgcn_sched_barrier(0);
        const int vw_off = (lane >> 3) * 144 + (lane & 7) * 16;
        const int tr_r = (lane & 15) >> 1;
        const int vr_off = ((tr_r < 4) ? (4 * g4 + tr_r) : (16 + 4 * g4 + tr_r - 4)) * 144 + 8 * (lane & 1);
#pragma unroll
        for (int k2 = 0; k2 < 8; ++k2) {
            const int slot = k2 % 3;
            __builtin_amdgcn_sched_barrier(0);
#pragma unroll
            for (int tl = 0; tl < 2; ++tl) { *(l2*)(sVw + tl * 2304 + vw_off) = vb[slot][tl][0]; *(l2*)(sVw + tl * 2304 + 8 * 144 + vw_off) = vb[slot][tl][1]; }
            LDS_FENCE();
#pragma unroll
            for (int db = 0; db < 8; ++db) {
                typedef int i2v __attribute__((ext_vector_type(2)));
                const i2v vt = __builtin_amdgcn_ds_read_tr8_b64_v2i32((LAS i2v*)(sVw + vr_off + db * 16));
                o[db] = __builtin_amdgcn_mfma_f32_16x16x32_fp8_fp8(__builtin_bit_cast(long, vt), pq[k2], o[db], 0, 0, 0);
            }
            LDS_FENCE();
            if (k2 + 3 < 8) { V_ISSUE(slot, k2 + 3); }
            __builtin_amdgcn_sched_barrier(0);
        }
#undef V_ISSUE
        if (n < 4) {
#pragma unroll
            for (int db = 0; db < 8; ++db) {
                h4 ov;
#pragma unroll
                for (int r = 0; r < 4; ++r) ov[r] = (hf)(o[db][r] * inv * (float)sgv[db][r]);
                *(h4*)(att + row * 1024 + h * 128 + db * 16 + 4 * g4) = ov;
            }
        }
#pragma unroll
        for (int j = 0; j < 4; ++j) sLn[lane * 4 + j] = (lane * 4 + j < ncnt) ? (u16)(nlv >> (16 * j)) : (u16)0;
        LDS_FENCE();
        if (inxt < 4096) {
            K_ISSUE_L(sLn, 0, 0); K_ISSUE_L(sLn, 1, 1);
            { const unsigned char* qp = q8 + ((size_t)b * SEQ + 2 * inxt + half) * 1024 + h * 128 + g4 * 16; qa = *(const l2*)qp; qb = *(const l2*)(qp + 64); }
        }
        icur = inxt; cnt = ncnt; buf ^= 1;
    }
#undef K_ISSUE_L
    }
    __syncthreads();
}

__global__ void __launch_bounds__(NTHR, 2) mega_fwd(Params P) {
    extern __shared__ __attribute__((aligned(16))) char smem[];
    unsigned char* ws = P.ws;
    const int lo = P.ph_lo, hi = P.ph_hi;
    LAS unsigned char* lds = (LAS unsigned char*)smem;
#if ONE_LAUNCH
    volatile LAS unsigned* st = (volatile LAS unsigned*)(smem + LDS_BYTES - 16);
    if (threadIdx.x == 0) { st[0] = 0u; st[1] = 0u; }
    __syncthreads();
    XcdBarrier bar = xcd_barrier_post((unsigned*)(ws + WS_BAR), st);
#define GRID_BAR() xcd_barrier(bar)
#else
#define GRID_BAR() do {} while (0)
#endif
#define IN(k) (lo <= (k) && (k) < hi)
#define SEAM(k) do { if (IN(k) && IN((k) + 1)) GRID_BAR(); } while (0)
#define PH_BEGIN(k) if (IN(k)) { for (int rep = 0; rep < (((k) == REP_PHASE) ? 1 + REP_N : 1); ++rep) {
#define PH_END(k) __syncthreads(); } } SEAM(k);
    PH_BEGIN(0) p0_prep(P, smem); PH_END(0)
    PH_BEGIN(1) { EpiIn0 E{&P}; pg8::gemm_phase(lds, (const hf*)(ws + WS_RA), (const hf*)(ws + WS_WT_IN0), 2048, 1024, E); } __syncthreads(); thin_kv(P, smem); PH_END(1)
    PH_BEGIN(2)
        for (int it = blockIdx.x; it < 256; it += gridDim.x) swa_item(P, it, smem);
        for (int it = blockIdx.x; it < 256; it += gridDim.x) ssm_item<0>(P, it, smem);
    PH_END(2)
    PH_BEGIN(3) carry_scan(P, smem); GRID_BAR(); for (int it = blockIdx.x; it < 256; it += gridDim.x) ssm_item<1>(P, it, smem); PH_END(3)
    PH_BEGIN(4) { EpiGlu E{&P}; pg8::gemm_phase(lds, (const hf*)(ws + WS_RC), (const hf*)(ws + WS_WT_GLU), 1024, 512, E); } PH_END(4)
    PH_BEGIN(5) { EpiOut0 E{&P}; pg8::gemm_phase(lds, (const hf*)(ws + WS_RA), (const hf*)(ws + WS_WT_OUT0), 1024, 1024, E); } PH_END(5)
    PH_BEGIN(6) { EpiIn1 E{&P}; pg8::gemm_phase(lds, (const hf*)(ws + WS_H1), (const hf*)(ws + WS_WT_IN1), 3072, 1024, E); } __syncthreads(); thin_ki(P, smem); PH_END(6)
    PH_BEGIN(7)
        for (int pr = blockIdx.x; pr < 256; pr += gridDim.x) {
            const int b = pr & 1, j = pr >> 1;
            h8 qf[8][2]; float wv[8];
            select_load_q(P, b, 511 - j, qf, wv);
#pragma unroll 1
            for (int s2 = 0; s2 < 4; ++s2) {
                const int n16 = (s2 == 0) ? (511 - j) : (s2 == 1) ? (256 + j) : (s2 == 2) ? (255 - j) : j;
                const int nxt = (s2 == 0) ? (256 + j) : (s2 == 1) ? (255 - j) : j;
                select_item(P, b, n16, s2 < 3, nxt, smem, qf, wv);
            }
        }
    PH_END(7)
    PH_BEGIN(8) dsa_attn_phase(P, smem); PH_END(8)
    PH_BEGIN(9) { EpiOut1 E{&P}; pg8::gemm_phase(lds, (const hf*)(ws + WS_RB), (const hf*)(ws + WS_WT_OUT1), 1024, 1024, E); } PH_END(9)
}

extern "C" void kernel_launch(void* const* d_in, const int* in_sizes, int n_in, void* d_out, int out_size, void* d_ws, size_t ws_size, hipStream_t stream) {
    static int grid = 0;
    if (grid == 0) {
        int dev = 0, cus = 0;
        if (n_in != 22 || out_size != MTOK * DM || ws_size < WS_END) { fprintf(stderr, "kernel_launch: unexpected shapes (n_in %d out %d ws %zu need %zu)\n", n_in, out_size, ws_size, (size_t)WS_END); grid = -1; return; }
        if (hipGetDevice(&dev) != hipSuccess || hipDeviceGetAttribute(&cus, hipDeviceAttributeMultiprocessorCount, dev) != hipSuccess) { grid = -1; return; }
        if (hipFuncSetAttribute((const void*)mega_fwd, hipFuncAttributeMaxDynamicSharedMemorySize, LDS_BYTES) != hipSuccess) { fprintf(stderr, "kernel_launch: hipFuncSetAttribute failed\n"); grid = -1; return; }
        grid = cus;
        if (grid < 8) grid = 8;
    }
    if (grid < 0) return;
    Params p{};
    for (int i = 0; i < 22; ++i) p.in[i] = (const float*)d_in[i];
    p.out = (float*)d_out; p.ws = (unsigned char*)d_ws;
#if ONE_LAUNCH
    (void)hipMemsetAsync((char*)d_ws + WS_BAR, 0, 16384, stream);
    p.ph_lo = 0; p.ph_hi = NPHASE;
    hipLaunchKernelGGL(mega_fwd, dim3(grid), dim3(NTHR), LDS_BYTES, stream, p);
#else
    for (int ph = 0; ph < NPHASE; ++ph) {
        p.ph_lo = ph; p.ph_hi = ph + 1;
        hipLaunchKernelGGL(mega_fwd, dim3(grid), dim3(NTHR), LDS_BYTES, stream, p);
    }
#endif
}
```
